# Optimizing an MI355X kernel written in HIP

```python
import jax, jax.numpy as jnp
from jax import lax
import numpy as np

D_MODEL = 2048
BATCH = 4
SEQ = 4096
DEPTH = 1

HEAD_DIM = 128
D_ATTN = D_MODEL // 2
N_ATTN_HEADS = D_ATTN // HEAD_DIM
D_GMLP = D_MODEL - D_ATTN
N_GMLP_HEADS = D_GMLP // HEAD_DIM
D_MIX = D_ATTN + D_GMLP
CHUNK = 128
Q_BLOCK = 128
D_FF = 4 * D_MODEL
D_IN_PROJ = 3 * D_ATTN + N_ATTN_HEADS + 2 * D_GMLP
EPS = 1e-6

kernel_name = "hymba_fox_gmlp_hybrid_block"


def rmsnorm(x, g):
    xf = x.astype(jnp.float32)
    y = xf * lax.rsqrt(jnp.mean(xf * xf, axis=-1, keepdims=True) + EPS)
    return (y * g.astype(jnp.float32)).astype(x.dtype)


def layernorm(x, g, b):
    xf = x.astype(jnp.float32)
    mu = jnp.mean(xf, axis=-1, keepdims=True)
    xc = xf - mu
    y = xc * lax.rsqrt(jnp.mean(xc * xc, axis=-1, keepdims=True) + EPS)
    return (y * g.astype(jnp.float32) + b.astype(jnp.float32)).astype(x.dtype)


def forgetting_attention(q, k, v, log_f):
    B, S, H, D = q.shape
    nb = S // Q_BLOCK
    scale = 1.0 / np.sqrt(D).astype(np.float32)
    F = jnp.cumsum(log_f, axis=1).transpose(0, 2, 1)
    q_blocks = q.reshape(B, nb, Q_BLOCK, H, D).transpose(1, 0, 2, 3, 4)
    F_blocks = F.reshape(B, H, nb, Q_BLOCK).transpose(2, 0, 1, 3)
    k_pos = jnp.arange(S)

    def one_block(args):
        qi, Fq, i = args
        s = jnp.einsum('bqhd,bkhd->bhqk', qi, k, preferred_element_type=jnp.float32) * scale
        s = s + Fq[..., :, None] - F[:, :, None, :]
        q_pos = i * Q_BLOCK + jnp.arange(Q_BLOCK)
        causal = k_pos[None, :] <= q_pos[:, None]
        s = jnp.where(causal[None, None], s, -jnp.inf)
        p = jax.nn.softmax(s, axis=-1)
        return jnp.einsum('bhqk,bkhd->bqhd', p.astype(v.dtype), v)

    out = lax.map(one_block, (q_blocks, F_blocks, jnp.arange(nb)))
    return out.transpose(1, 0, 2, 3, 4).reshape(B, S, H * D)


def chunked_spatial_gating(zu, zv, ln_g, ln_b, w_s, b_s):
    B, S, _ = zu.shape
    nc = S // CHUNK
    u = jax.nn.gelu(zu)
    v = layernorm(jax.nn.gelu(zv), ln_g, ln_b)
    v = v.reshape(B, nc, CHUNK, N_GMLP_HEADS, HEAD_DIM)
    w_causal = jnp.tril(w_s)
    mix = jnp.einsum('hts,bcshd->bcthd', w_causal.astype(v.dtype), v)
    mix = mix + b_s.T[None, None, :, :, None]
    out = u.reshape(B, nc, CHUNK, N_GMLP_HEADS, HEAD_DIM) * mix
    return out.reshape(B, S, D_GMLP)


def setup_inputs(seed: int = 0) -> dict:
    key = jax.random.key(seed)
    ks = jax.random.split(key, 20)
    L = DEPTH
    nrm = jax.random.normal
    x = nrm(ks[0], (BATCH, SEQ, D_MODEL), jnp.float32)
    norm_mix_g = 1.0 + 0.02 * nrm(ks[1], (L, D_MODEL), jnp.float32)
    w_qkv = nrm(ks[2], (L, D_MODEL, 3 * D_ATTN), jnp.float32) * D_MODEL ** -0.5
    w_f = nrm(ks[3], (L, D_MODEL, N_ATTN_HEADS), jnp.float32) * 0.1 * D_MODEL ** -0.5
    w_g = nrm(ks[4], (L, D_MODEL, 2 * D_GMLP), jnp.float32) * D_MODEL ** -0.5
    w_in = jnp.concatenate([w_qkv, w_f, w_g], axis=-1)
    b_f = jax.random.uniform(ks[5], (L, N_ATTN_HEADS), jnp.float32, 1.0, 5.0)
    gmlp_ln_g = 1.0 + 0.02 * nrm(ks[6], (L, D_GMLP), jnp.float32)
    gmlp_ln_b = 0.02 * nrm(ks[7], (L, D_GMLP), jnp.float32)
    w_s = nrm(ks[8], (L, N_GMLP_HEADS, CHUNK, CHUNK), jnp.float32) * CHUNK ** -0.5
    b_s = 1.0 + 0.1 * nrm(ks[9], (L, N_GMLP_HEADS, CHUNK), jnp.float32)
    attn_out_g = 1.0 + 0.02 * nrm(ks[10], (L, D_ATTN), jnp.float32)
    gmlp_out_g = 1.0 + 0.02 * nrm(ks[11], (L, D_GMLP), jnp.float32)
    w_out = nrm(ks[12], (L, D_MIX, D_MODEL), jnp.float32) * D_MIX ** -0.5
    norm_ffn_g = 1.0 + 0.02 * nrm(ks[13], (L, D_MODEL), jnp.float32)
    w_ff1 = nrm(ks[14], (L, D_MODEL, D_FF), jnp.float32) * D_MODEL ** -0.5
    w_ff2 = nrm(ks[15], (L, D_FF, D_MODEL), jnp.float32) * D_FF ** -0.5
    norm_final_g = 1.0 + 0.02 * nrm(ks[16], (D_MODEL,), jnp.float32)
    return {"x": x, "norm_mix_g": norm_mix_g, "w_in": w_in, "b_f": b_f,
            "gmlp_ln_g": gmlp_ln_g, "gmlp_ln_b": gmlp_ln_b, "w_s": w_s, "b_s": b_s,
            "attn_out_g": attn_out_g, "gmlp_out_g": gmlp_out_g, "w_out": w_out,
            "norm_ffn_g": norm_ffn_g, "w_ff1": w_ff1, "w_ff2": w_ff2,
            "norm_final_g": norm_final_g}


def reference(x, norm_mix_g, w_in, b_f, gmlp_ln_g, gmlp_ln_b, w_s, b_s,
              attn_out_g, gmlp_out_g, w_out, norm_ffn_g, w_ff1, w_ff2, norm_final_g):
    B, S, _ = x.shape
    for l in range(DEPTH):
        h = rmsnorm(x, norm_mix_g[l])
        z = jnp.einsum('bsd,de->bse', h, w_in[l])
        o1 = D_ATTN; o2 = 2 * D_ATTN; o3 = 3 * D_ATTN; o4 = o3 + N_ATTN_HEADS
        q = z[..., :o1].reshape(B, S, N_ATTN_HEADS, HEAD_DIM)
        k = z[..., o1:o2].reshape(B, S, N_ATTN_HEADS, HEAD_DIM)
        v = z[..., o2:o3].reshape(B, S, N_ATTN_HEADS, HEAD_DIM)
        log_f = jax.nn.log_sigmoid(z[..., o3:o4].astype(jnp.float32) + b_f[l].astype(jnp.float32))
        zu = z[..., o4:o4 + D_GMLP]
        zv = z[..., o4 + D_GMLP:]
        attn = forgetting_attention(q, k, v, log_f)
        gm = chunked_spatial_gating(zu, zv, gmlp_ln_g[l], gmlp_ln_b[l], w_s[l], b_s[l])
        merged = jnp.concatenate([rmsnorm(attn, attn_out_g[l]),
                                  rmsnorm(gm, gmlp_out_g[l])], axis=-1)
        x = x + jnp.einsum('bse,ed->bsd', merged, w_out[l])
        h2 = rmsnorm(x, norm_ffn_g[l])
        a = jax.nn.relu(jnp.einsum('bsd,df->bsf', h2, w_ff1[l]))
        x = x + jnp.einsum('bsf,fd->bsd', a * a, w_ff2[l])
    return rmsnorm(x, norm_final_g)
```

```cpp
#include <hip/hip_runtime.h>
#include <hip/hip_cooperative_groups.h>
#include <hip/hip_bf16.h>
#include <cstdio>
#include <cstdint>
#include <cmath>
namespace pg8 {
#define PG8_LAS __attribute__((address_space(3)))
typedef unsigned short bf16_t;
typedef short bf16x8 __attribute__((ext_vector_type(8)));
typedef float f32x4 __attribute__((ext_vector_type(4)));
typedef unsigned u32x4 __attribute__((ext_vector_type(4)));
constexpr int BM = 256, BK = 64, HALF = 128, HTB = HALF * BK * 2  , STAGE_BYTES = 8 * HTB, NXCD = 8, WGM = 8;

__host__ __device__ __forceinline__ int lds_byte(int r, int c) { const int st = (r >> 4) * 2 + (c >> 5), rr = r & 15, cc = c & 31, ob = rr * 64 + cc * 2; return st * 1024 + (ob ^ (((ob >> 9) & 1) << 5)); }
__host__ __device__ __forceinline__ void stage_rc(int b, int& R, int& C) { const int st = b / 1024, sb = b % 1024, swz = sb ^ (((sb >> 9) & 1) << 5); R = (st >> 1) * 16 + swz / 64; C = (st & 1) * 32 + (swz % 64) / 2; }
__host__ __device__ __forceinline__ int perm32(int rho) { const int n = rho >> 4, i = rho & 15; return 8 * (i >> 2) + 4 * n + (i & 3); }

struct Unit { int pm, pn; };
struct Gemm { const bf16_t* A; const bf16_t* Bt; int M, N, K; };

struct StaticOrder {
    int nM, nN, nwg, G, c;
    __host__ __device__ void init(int M, int N, int G_, int c_) { nM = M / BM; nN = N / BM; nwg = nM * nN; G = G_; c = c_; }
    __host__ __device__ bool next(int i, Unit& u) const {
        const long L = (long)i * G + c; if (L >= nwg) return false;
        int wgid = (int)L; { const int q = nwg / NXCD, r = nwg % NXCD, xcd = wgid % NXCD, off = wgid / NXCD; wgid = (xcd < r ? xcd * (q + 1) : r * (q + 1) + (xcd - r) * q) + off; }
        const int nig = WGM * nN, gid = wgid / nig, fm = gid * WGM, gsz = (nM - fm) < WGM ? (nM - fm) : WGM;
        u.pm = fm + ((wgid % nig) % gsz); u.pn = (wgid % nig) / gsz; return true;
    }
    __device__ __forceinline__ void a_ready(const Unit&) const {}
    __device__ __forceinline__ void done(const Unit&) const {}
};

__device__ __forceinline__ unsigned cvt_pk_bf16(float lo, float hi) { unsigned r; asm volatile("v_cvt_pk_bf16_f32 %0, %1, %2" : "=v"(r) : "v"(lo), "v"(hi)); return r; }
typedef float f32x2 __attribute__((ext_vector_type(2)));
typedef unsigned u32x2 __attribute__((ext_vector_type(2)));
__device__ __forceinline__ float gelu_tanh(float v) {
    const float t = v * (1.0f + 0.044715f * v * v);
    const float e = __builtin_amdgcn_exp2f(-2.302208198f * t);
    return v * __builtin_amdgcn_rcpf(1.0f + e);
}
constexpr int SEQ_ = 4096, NH_ = 8;
struct EpiIn {
    static constexpr bool PERM = true, AFTER_DRAIN = false, MIDHOOK = false;
    bf16_t* Q; bf16_t* Kk; bf16_t* V; bf16_t* U; bf16_t* Y; float* lnst;
    __device__ __forceinline__ void operator()(const f32x4 (&acc)[2][2][4][2], const Unit& u, int wr, int wc, int fr, int fq) const {
        const int grp = u.pn >> 2, sub = u.pn & 3;
        const int row0 = u.pm * BM + wr * 64 + fr;
        if (grp < 3) {
            bf16_t* base = Q + (size_t)grp * (size_t)(16u << 20);
#pragma unroll
            for (int ai = 0; ai < 2; ++ai)
#pragma unroll
                for (int m = 0; m < 4; ++m) { const int row = row0 + ai * HALF + m * 16; const int b = row / SEQ_, s = row % SEQ_;
#pragma unroll
                    for (int bj = 0; bj < 2; ++bj) { const int head = sub * 2 + bj;
                        bf16_t* p = base + ((size_t)(b * NH_ + head) * SEQ_ + s) * 128 + wc * 32 + 8 * fq;
                        const f32x4 v0 = acc[ai][bj][m][0], v1 = acc[ai][bj][m][1];
                        u32x4 w; w.x = cvt_pk_bf16(v0[0], v0[1]); w.y = cvt_pk_bf16(v0[2], v0[3]); w.z = cvt_pk_bf16(v1[0], v1[1]); w.w = cvt_pk_bf16(v1[2], v1[3]);
                        *(u32x4*)p = w; } }
        } else {
            bf16_t* base = Q + (size_t)grp * (size_t)(16u << 20);
#pragma unroll
            for (int ai = 0; ai < 2; ++ai)
#pragma unroll
                for (int m = 0; m < 4; ++m) { const int row = row0 + ai * HALF + m * 16;
                    bf16_t* rowp = base + (size_t)row * 1024 + sub * 256 + wc * 32 + 8 * fq;
                    float s1 = 0.f, s2 = 0.f;
#pragma unroll
                    for (int bj = 0; bj < 2; ++bj) { const f32x4 v0 = acc[ai][bj][m][0], v1 = acc[ai][bj][m][1];
                        u32x4 w; w.x = cvt_pk_bf16(gelu_tanh(v0[0]), gelu_tanh(v0[1])); w.y = cvt_pk_bf16(gelu_tanh(v0[2]), gelu_tanh(v0[3]));
                        w.z = cvt_pk_bf16(gelu_tanh(v1[0]), gelu_tanh(v1[1])); w.w = cvt_pk_bf16(gelu_tanh(v1[2]), gelu_tanh(v1[3]));
                        *(u32x4*)(rowp + bj * HALF) = w;
                        if (grp == 4) {
#pragma unroll
                            for (int e = 0; e < 4; ++e) { const float lo = __uint_as_float(w[e] << 16), hi = __uint_as_float(w[e] & 0xffff0000u); s1 += lo + hi; s2 += lo * lo + hi * hi; } } }
                    if (grp == 4) { s1 += __shfl_xor(s1, 16); s1 += __shfl_xor(s1, 32); s2 += __shfl_xor(s2, 16); s2 += __shfl_xor(s2, 32);
                        if (fq == 0) *(f32x2*)(lnst + ((size_t)row * 16 + sub * 4 + wc) * 2) = (f32x2){s1, s2}; } }
        }
    }
};
struct EpiRes {
    static constexpr bool PERM = true, AFTER_DRAIN = false, MIDHOOK = true;
    const float* X; bf16_t* X1b; const PG8_LAS f32x2* tab;
    __device__ __forceinline__ void mid(f32x4 (&acc)[2][2][4][2], int ui, int wr, int fr) const {
#pragma unroll
        for (int ai = 0; ai < 2; ++ai)
#pragma unroll
            for (int m = 0; m < 4; ++m) { const float ratio = tab[ui * BM + ai * HALF + wr * 64 + m * 16 + fr].x;
#pragma unroll
                for (int bj = 0; bj < 2; ++bj)
#pragma unroll
                    for (int n = 0; n < 2; ++n) acc[ai][bj][m][n] = acc[ai][bj][m][n] * ratio; }
    }
    __device__ __forceinline__ void operator()(const f32x4 (&acc)[2][2][4][2], const Unit& u, int ui, int wr, int wc, int fr, int fq) const {
        const int row0 = u.pm * BM + wr * 64 + fr, col0 = u.pn * BM + wc * 32 + 8 * fq;
#pragma unroll
        for (int ai = 0; ai < 2; ++ai)
#pragma unroll
            for (int m = 0; m < 4; ++m) { const size_t off = (size_t)(row0 + ai * HALF + m * 16) * 2048 + col0; const float rsg = tab[ui * BM + ai * HALF + wr * 64 + m * 16 + fr].y;
#pragma unroll
                for (int bj = 0; bj < 2; ++bj) { const f32x4 o0 = *(const f32x4*)(X + off + bj * HALF) + acc[ai][bj][m][0] * rsg, o1 = *(const f32x4*)(X + off + bj * HALF + 4) + acc[ai][bj][m][1] * rsg;
                    u32x4 w; w.x = cvt_pk_bf16(o0[0], o0[1]); w.y = cvt_pk_bf16(o0[2], o0[3]); w.z = cvt_pk_bf16(o1[0], o1[1]); w.w = cvt_pk_bf16(o1[2], o1[3]);
                    *(u32x4*)(X1b + off + bj * HALF) = w; } }
    }
};
struct EpiRelu2 {
    static constexpr bool PERM = true, AFTER_DRAIN = false, MIDHOOK = false;
    bf16_t* O; int ldc;
    __device__ __forceinline__ void operator()(const f32x4 (&acc)[2][2][4][2], const Unit& u, int wr, int wc, int fr, int fq) const {
        const int row0 = u.pm * BM + wr * 64 + fr, col0 = u.pn * BM + wc * 32 + 8 * fq;
#pragma unroll
        for (int ai = 0; ai < 2; ++ai)
#pragma unroll
            for (int m = 0; m < 4; ++m) { bf16_t* rowp = O + (size_t)(row0 + ai * HALF + m * 16) * ldc + col0;
#pragma unroll
                for (int bj = 0; bj < 2; ++bj) { f32x4 v0 = acc[ai][bj][m][0], v1 = acc[ai][bj][m][1];
#pragma unroll
                    for (int e = 0; e < 4; ++e) { const float a = fmaxf(v0[e], 0.f), b = fmaxf(v1[e], 0.f); v0[e] = a * a; v1[e] = b * b; }
                    u32x4 w; w.x = cvt_pk_bf16(v0[0], v0[1]); w.y = cvt_pk_bf16(v0[2], v0[3]); w.z = cvt_pk_bf16(v1[0], v1[1]); w.w = cvt_pk_bf16(v1[2], v1[3]);
                    *(u32x4*)(rowp + bj * HALF) = w; } }
    }
};
struct EpiY16 {
    static constexpr bool PERM = true, AFTER_DRAIN = false, MIDHOOK = false;
    bf16_t* Yo;
    __device__ __forceinline__ void operator()(const f32x4 (&acc)[2][2][4][2], const Unit& u, int wr, int wc, int fr, int fq) const {
        const int row0 = u.pm * BM + wr * 64 + fr, col0 = u.pn * BM + wc * 32 + 8 * fq;
#pragma unroll
        for (int ai = 0; ai < 2; ++ai)
#pragma unroll
            for (int m = 0; m < 4; ++m) { bf16_t* rowp = Yo + (size_t)(row0 + ai * HALF + m * 16) * 2048 + col0;
#pragma unroll
                for (int bj = 0; bj < 2; ++bj) { const f32x4 v0 = acc[ai][bj][m][0], v1 = acc[ai][bj][m][1];
                    u32x4 w; w.x = cvt_pk_bf16(v0[0], v0[1]); w.y = cvt_pk_bf16(v0[2], v0[3]); w.z = cvt_pk_bf16(v1[0], v1[1]); w.w = cvt_pk_bf16(v1[2], v1[3]);
                    *(u32x4*)(rowp + bj * HALF) = w; } }
    }
};

template <class Epi, class Sched, bool ALIGN_EPI = false, bool SP2 = false>
__device__ __forceinline__ void gemm_phase(PG8_LAS unsigned char* lds, const Gemm g, const Sched& S, const Epi& E, const int tid) {
    const int wid = __builtin_amdgcn_readfirstlane(tid >> 6), lane = tid & 63, wr = wid >> 2, wc = wid & 3, fr = lane & 15, fq = lane >> 4;
    const int K = g.K, nt = K / BK;
    unsigned voffA[2], voffB[2];
#pragma unroll
    for (int i = 0; i < 2; ++i) { int R, C; stage_rc(tid * 16 + i * 8192, R, C); const int Rb = Epi::PERM ? ((R & ~31) + perm32(R & 31)) : R;
        voffA[i] = (unsigned)(R * K + C) * 2u; voffB[i] = (unsigned)(Rb * K + C) * 2u; }
    const size_t kstep = (size_t)(BK * 2);
    const size_t hstep = (size_t)HALF * K * 2;
    const size_t tstep = 2 * hstep;
    const unsigned ldsw = (unsigned)wid * 1024u;
    const int aoff = lds_byte(wr * 64 + fr, fq * 8), boff = lds_byte(wc * 32 + fr, fq * 8);
#define PG8_SA(b, h) (((b) * 2 + (h)) * HTB)
#define PG8_SB(b, h) ((4 + (b) * 2 + (h)) * HTB)
#define PG8_STAGE(bufoff, gbase, voff) do { _Pragma("unroll") for (int _i = 0; _i < 2; ++_i) \
        __builtin_amdgcn_global_load_lds((const unsigned*)((const char*)(gbase) + (voff)[_i]), (PG8_LAS unsigned*)(lds + (bufoff) + ldsw + _i * 8192), 16, 0, 0); } while (0)
#define PG8_LDA(dst, b, h) do { _Pragma("unroll") for (int m = 0; m < 4; ++m) _Pragma("unroll") for (int k = 0; k < 2; ++k) dst[m][k] = *(const PG8_LAS bf16x8*)(lds + PG8_SA(b, h) + aoff + m * 2048 + k * 1024); } while (0)
#define PG8_LDB(dst, b, h) do { _Pragma("unroll") for (int n = 0; n < 2; ++n) _Pragma("unroll") for (int k = 0; k < 2; ++k) dst[n][k] = *(const PG8_LAS bf16x8*)(lds + PG8_SB(b, h) + boff + n * 2048 + k * 1024); } while (0)
#define PG8_MMA(ai, bj, At, Bt) do { __builtin_amdgcn_s_setprio(1); _Pragma("unroll") for (int m = 0; m < 4; ++m) _Pragma("unroll") for (int n = 0; n < 2; ++n) _Pragma("unroll") for (int k = 0; k < 2; ++k) \
        acc[ai][bj][m][n] = __builtin_amdgcn_mfma_f32_16x16x32_bf16(Bt[n][k], At[m][k], acc[ai][bj][m][n], 0, 0, 0); __builtin_amdgcn_s_setprio(0); } while (0)
#define PG8_WAIT_V(n) asm volatile("s_waitcnt vmcnt(" #n ")" ::: "memory")
#define PG8_WAIT_L(n) asm volatile("s_waitcnt lgkmcnt(" #n ")" ::: "memory")
#define PG8_BAR __builtin_amdgcn_s_barrier()
#define PG8_SCHED __builtin_amdgcn_sched_barrier(0)
    Unit cur, nxt; int ui = 0;
    if (!S.next(0, cur)) return;
    f32x4 acc[2][2][4][2];
#pragma unroll
    for (int a = 0; a < 2; ++a)
#pragma unroll
        for (int b = 0; b < 2; ++b)
#pragma unroll
            for (int m = 0; m < 4; ++m)
#pragma unroll
                for (int n = 0; n < 2; ++n) acc[a][b][m][n] = (f32x4){0.f, 0.f, 0.f, 0.f};
    bf16x8 At[4][2], B0[2][2], B1[2][2];
    const char* cA = (const char*)g.A + (size_t)cur.pm * tstep; const char* cB = (const char*)g.Bt + (size_t)cur.pn * tstep;
    S.a_ready(cur);
    if constexpr (SP2) {
        PG8_STAGE(PG8_SB(0, 0), cB, voffB); PG8_STAGE(PG8_SB(0, 1), cB + hstep, voffB); PG8_STAGE(PG8_SA(0, 0), cA, voffA); PG8_STAGE(PG8_SA(0, 1), cA + hstep, voffA);
        if (wr == 1) PG8_BAR;
        PG8_WAIT_V(2); PG8_BAR;
        PG8_STAGE(PG8_SB(1, 0), cB + kstep, voffB); PG8_STAGE(PG8_SA(1, 0), cA + kstep, voffA); PG8_STAGE(PG8_SB(1, 1), cB + hstep + kstep, voffB);
        PG8_WAIT_V(6); PG8_BAR;
    } else {
        PG8_STAGE(PG8_SB(0, 0), cB, voffB); PG8_STAGE(PG8_SA(0, 0), cA, voffA); PG8_STAGE(PG8_SB(0, 1), cB + hstep, voffB); PG8_STAGE(PG8_SA(0, 1), cA + hstep, voffA);
        if (wr == 1) PG8_BAR;
        PG8_WAIT_V(4); PG8_BAR;
        PG8_STAGE(PG8_SB(1, 0), cB + kstep, voffB); PG8_STAGE(PG8_SA(1, 0), cA + kstep, voffA); PG8_STAGE(PG8_SB(1, 1), cB + hstep + kstep, voffB);
        PG8_WAIT_V(6); PG8_BAR;
    }
    for (;;) {
        const bool has_next = S.next(ui + 1, nxt);
        const char* nA = has_next ? (const char*)g.A + (size_t)nxt.pm * tstep : cA; const char* nB = has_next ? (const char*)g.Bt + (size_t)nxt.pn * tstep : cB;
        for (int t = 0; t < nt; t += 2) {
            if constexpr (Epi::MIDHOOK) { if (t == (nt >> 1)) E.mid(acc, ui, wr, fr); }
            const bool last = (t == nt - 2);
            const char* a1 = cA + (size_t)(t + 1) * kstep;
            const char* a2 = last ? nA : cA + (size_t)(t + 2) * kstep; const char* b2 = last ? nB : cB + (size_t)(t + 2) * kstep;
            const char* a3 = a2 + kstep; const char* b3 = b2 + kstep;
            if (last && has_next) S.a_ready(nxt);
            if constexpr (SP2) {
            PG8_LDB(B0, 0, 0); PG8_LDB(B1, 0, 1); PG8_SCHED; PG8_LDA(At, 0, 0); PG8_STAGE(PG8_SA(1, 1), a1 + hstep, voffA);
            PG8_WAIT_V(8); PG8_WAIT_L(0); PG8_BAR; PG8_MMA(0, 0, At, B0); PG8_MMA(0, 1, At, B1); PG8_BAR; PG8_SCHED;
            PG8_LDA(At, 0, 1); PG8_STAGE(PG8_SB(0, 0), b2, voffB); PG8_STAGE(PG8_SB(0, 1), b2 + hstep, voffB); PG8_STAGE(PG8_SA(0, 0), a2, voffA);
            PG8_WAIT_V(8); PG8_WAIT_L(0); PG8_BAR; PG8_MMA(1, 0, At, B0); PG8_MMA(1, 1, At, B1); PG8_BAR; PG8_SCHED;
            PG8_LDB(B0, 1, 0); PG8_LDB(B1, 1, 1); PG8_SCHED; PG8_LDA(At, 1, 0); PG8_STAGE(PG8_SA(0, 1), a2 + hstep, voffA);
            PG8_WAIT_V(8); PG8_WAIT_L(0); PG8_BAR; PG8_MMA(0, 0, At, B0); PG8_MMA(0, 1, At, B1); PG8_BAR; PG8_SCHED;
            PG8_LDA(At, 1, 1); PG8_STAGE(PG8_SB(1, 0), b3, voffB); PG8_STAGE(PG8_SB(1, 1), b3 + hstep, voffB); PG8_STAGE(PG8_SA(1, 0), a3, voffA);
            PG8_WAIT_V(8); PG8_WAIT_L(0); PG8_BAR; PG8_MMA(1, 0, At, B0); PG8_MMA(1, 1, At, B1); PG8_BAR; PG8_SCHED;
            } else {
            PG8_LDB(B0, 0, 0); PG8_SCHED; PG8_LDA(At, 0, 0); PG8_STAGE(PG8_SA(1, 1), a1 + hstep, voffA);
            PG8_WAIT_L(8); PG8_BAR; PG8_WAIT_L(0); PG8_MMA(0, 0, At, B0); PG8_BAR; PG8_SCHED;
            PG8_LDB(B1, 0, 1); PG8_STAGE(PG8_SB(0, 0), b2, voffB);
            PG8_BAR; PG8_WAIT_L(0); PG8_MMA(0, 1, At, B1); PG8_BAR;
            PG8_LDA(At, 0, 1); PG8_STAGE(PG8_SA(0, 0), a2, voffA);
            PG8_BAR; PG8_WAIT_L(0); PG8_MMA(1, 0, At, B0); PG8_BAR; PG8_SCHED;
            PG8_STAGE(PG8_SB(0, 1), b2 + hstep, voffB);
            PG8_WAIT_V(6); PG8_BAR; PG8_MMA(1, 1, At, B1); PG8_BAR;
            PG8_LDB(B0, 1, 0); PG8_SCHED; PG8_LDA(At, 1, 0); PG8_STAGE(PG8_SA(0, 1), a2 + hstep, voffA);
            PG8_WAIT_L(8); PG8_BAR; PG8_WAIT_L(0); PG8_MMA(0, 0, At, B0); PG8_BAR; PG8_SCHED;
            PG8_LDB(B1, 1, 1); PG8_STAGE(PG8_SB(1, 0), b3, voffB);
            PG8_BAR; PG8_WAIT_L(0); PG8_MMA(0, 1, At, B1); PG8_BAR;
            PG8_LDA(At, 1, 1); PG8_STAGE(PG8_SA(1, 0), a3, voffA);
            PG8_BAR; PG8_WAIT_L(0); PG8_MMA(1, 0, At, B0); PG8_BAR; PG8_SCHED;
            PG8_STAGE(PG8_SB(1, 1), b3 + hstep, voffB);
            PG8_WAIT_V(6); PG8_BAR; PG8_MMA(1, 1, At, B1); PG8_BAR;
            }
        }
        if constexpr (ALIGN_EPI) { if (wr == 0) PG8_BAR; }
        if constexpr (!Epi::AFTER_DRAIN) { if constexpr (Epi::MIDHOOK) E(acc, cur, ui, wr, wc, fr, fq); else E(acc, cur, wr, wc, fr, fq); S.done(cur); }
        if (!has_next) break;
#pragma unroll
        for (int a = 0; a < 2; ++a)
#pragma unroll
            for (int b = 0; b < 2; ++b)
#pragma unroll
                for (int m = 0; m < 4; ++m)
#pragma unroll
                    for (int n = 0; n < 2; ++n) acc[a][b][m][n] = (f32x4){0.f, 0.f, 0.f, 0.f};
        cur = nxt; cA = nA; cB = nB; ++ui;
        if constexpr (ALIGN_EPI) { if (wr == 1) PG8_BAR; }
    }
    PG8_WAIT_V(0);
    if constexpr (!ALIGN_EPI) { if (wr == 0) PG8_BAR; }
    PG8_BAR;
    if constexpr (Epi::AFTER_DRAIN) { E.fused(acc, cur, wr, wc, fr, fq, lds, wid, lane); S.done(cur); }
#undef PG8_SA
#undef PG8_SB
#undef PG8_STAGE
#undef PG8_LDA
#undef PG8_LDB
#undef PG8_MMA
#undef PG8_WAIT_V
#undef PG8_WAIT_L
#undef PG8_BAR
#undef PG8_SCHED
}
}
namespace att {
using bf16 = __hip_bfloat16;
typedef short bf16x8 __attribute__((ext_vector_type(8)));
typedef short s16x4 __attribute__((ext_vector_type(4)));
typedef float f32x16 __attribute__((ext_vector_type(16)));
typedef float f32x4 __attribute__((ext_vector_type(4)));
typedef unsigned u32x4 __attribute__((ext_vector_type(4)));
constexpr int D = 128, SEQ = 4096, OP = 2048;
constexpr float SCALE = 0.08838834764831845f, THR = 8.f;
constexpr int NW = 8, QBLK = 32, KVBLK = 64, QB = NW * QBLK;
constexpr int SHM_V = KVBLK * D * 2, SHM_K = KVBLK * D * 2;
constexpr int OFF_WS = 2 * SHM_V + 2 * SHM_K, OFF_BIAS = OFF_WS + NW * 64 * 4, BIAS_BYTES = SEQ * 4, LDS_BYTES = OFF_BIAS + 2 * BIAS_BYTES;

#define KSWZ(row, colB) ((row) * 256 + ((colB) ^ (((row) & 7) << 4)))
#define SBAR() __builtin_amdgcn_sched_barrier(0)
__device__ __forceinline__ int v_st(int k, int c) { const int kk = (k & ~0xC) | ((k & 4) << 1) | ((k & 8) >> 1); return ((kk >> 3) * 4 + (c >> 5)) * 512 + ((kk & 7) * 32 + (c & 31)) * 2; }
__device__ __forceinline__ int v_rd_base(int lane) { return ((lane & 3) << 3) | (((lane >> 2) & 3) << 6) | (((lane >> 4) & 1) << 5) | (((lane >> 5) & 1) << 8); }
constexpr int v_rd_off(int d0, int ks, int half) { return d0 * 512 + ks * 4096 + half * 2048; }
__device__ __forceinline__ int crow(int r, int hi) { return (r & 3) + 8 * (r >> 2) + 4 * hi; }
__device__ __forceinline__ unsigned cvtpk(float lo, float hi) { unsigned r; asm volatile("v_cvt_pk_bf16_f32 %0, %1, %2" : "=v"(r) : "v"(lo), "v"(hi)); return r; }
__device__ __forceinline__ bf16x8 load8(const bf16* p) { return *reinterpret_cast<const bf16x8*>(p); }
__device__ __forceinline__ bf16x8 ldg16(const char* sb, unsigned off) { return *reinterpret_cast<const bf16x8*>(sb + off); }
__device__ __forceinline__ void mask_tile(f32x16& p0, f32x16& p1, int dq, unsigned W) {
    const float NEG = -__builtin_inff();
#pragma unroll
    for (int r = 0; r < 16; ++r) {
        const int c = (r & 3) + 8 * (r >> 2);
        if ((unsigned)(dq - c) >= W) p0[r] = NEG;
        if ((unsigned)(dq - c - 32) >= W) p1[r] = NEG;
    }
}
__device__ __forceinline__ void partialSM(f32x16& p0, f32x16& p1, float& m_reg, float& mn, float& alpha) {
    float pmax = p0[0]; for (int r = 1; r < 16; ++r) pmax = fmaxf(pmax, p0[r]); for (int r = 0; r < 16; ++r) pmax = fmaxf(pmax, p1[r]);
    { auto rr = __builtin_amdgcn_permlane32_swap(__float_as_uint(pmax), __float_as_uint(pmax), false, false);
      pmax = fmaxf(__uint_as_float(rr[0]), __uint_as_float(rr[1])); }
    constexpr float C2 = 1.4426950408889634f * SCALE;
    if (__builtin_expect(__all((pmax - m_reg) * SCALE <= THR), 1)) { mn = m_reg; alpha = 1.f; }
    else { mn = fmaxf(m_reg, pmax); alpha = __builtin_amdgcn_exp2f((m_reg - mn) * C2); m_reg = mn; }
    const float mnL = -mn * C2;
    for (int r = 0; r < 16; ++r) p0[r] = fmaf(p0[r], C2, mnL); for (int r = 0; r < 16; ++r) p1[r] = fmaf(p1[r], C2, mnL);
    for (int r = 0; r < 16; ++r) p0[r] = __builtin_amdgcn_exp2f(p0[r]);
}
__device__ __forceinline__ void finishSM(f32x16& p0, f32x16& p1, float alpha, float& l_reg, bf16x8& pa0, bf16x8& pa1, bf16x8& pa2, bf16x8& pa3) {
    for (int r = 0; r < 16; ++r) p1[r] = __builtin_amdgcn_exp2f(p1[r]);
    float ps = 0; for (int r = 0; r < 16; ++r) ps += p0[r]; for (int r = 0; r < 16; ++r) ps += p1[r];
    { auto rr = __builtin_amdgcn_permlane32_swap(__float_as_uint(ps), __float_as_uint(ps), false, false);
      ps = __uint_as_float(rr[0]) + __uint_as_float(rr[1]); }
    l_reg = l_reg * alpha + ps;
#define PK4(P, B_, OUT) do { unsigned a0 = cvtpk(P[B_+0], P[B_+1]), a1 = cvtpk(P[B_+2], P[B_+3]);                          \
        unsigned b0 = cvtpk(P[B_+4], P[B_+5]), b1 = cvtpk(P[B_+6], P[B_+7]);                                             \
        auto r0 = __builtin_amdgcn_permlane32_swap(a0, b0, false, false); auto r1 = __builtin_amdgcn_permlane32_swap(a1, b1, false, false); \
        u32x4 w = {r0[0], r1[0], r0[1], r1[1]}; OUT = *reinterpret_cast<bf16x8*>(&w); } while (0)
    PK4(p0, 0, pa0); PK4(p0, 8, pa1); PK4(p1, 0, pa2); PK4(p1, 8, pa3);
#undef PK4
}
template <int KB>
__device__ __forceinline__ void qkt(f32x16& p0, f32x16& p1, const char* K_lds, int r32, int hi, const bf16x8* qr, const float* bp) {
#pragma unroll
    for (int g = 0; g < 4; ++g) { const f32x4 a = *(const f32x4*)(bp + 8 * g), b = *(const f32x4*)(bp + 32 + 8 * g);
        p0[4 * g] = a[0]; p0[4 * g + 1] = a[1]; p0[4 * g + 2] = a[2]; p0[4 * g + 3] = a[3];
        p1[4 * g] = b[0]; p1[4 * g + 1] = b[1]; p1[4 * g + 2] = b[2]; p1[4 * g + 3] = b[3]; }
    const char* kb[4];
#pragma unroll
    for (int dd = 0; dd < 4; ++dd) kb[dd] = K_lds + KB * SHM_K + KSWZ(r32, (dd * 16 + hi * 8) * 2);
#pragma unroll
    for (int d0 = 0; d0 < 8; ++d0) { const char* a = kb[d0 & 3] + (d0 >> 2) * 128;
        bf16x8 b0 = *reinterpret_cast<const bf16x8*>(a);
        bf16x8 b1 = *reinterpret_cast<const bf16x8*>(a + 32 * 256);
        p0 = __builtin_amdgcn_mfma_f32_32x32x16_bf16(b0, qr[d0], p0, 0, 0, 0);
        p1 = __builtin_amdgcn_mfma_f32_32x32x16_bf16(b1, qr[d0], p1, 0, 0, 0); }
}
#define TRRD(dst, off) asm volatile("ds_read_b64_tr_b16 %0, %1 offset:%2" : "=&v"(dst) : "v"(vb0), "i"(off) : "memory")
#define PV_D0(VB, d0, oo) do { s16x4 l0, l1, l2, l3, h0, h1, h2, h3; constexpr int b_ = (VB) * SHM_V + v_rd_off(d0, 0, 0);   \
        TRRD(l0, b_); TRRD(h0, b_ + 2048); TRRD(l1, b_ + 4096); TRRD(h1, b_ + 6144); TRRD(l2, b_ + 8192); TRRD(h2, b_ + 10240); TRRD(l3, b_ + 12288); TRRD(h3, b_ + 14336); \
        asm volatile("s_waitcnt lgkmcnt(0)" ::: "memory"); SBAR();                                                          \
        oo = __builtin_amdgcn_mfma_f32_32x32x16_bf16(pa0, (bf16x8){l0[0], l0[1], l0[2], l0[3], h0[0], h0[1], h0[2], h0[3]}, oo, 0, 0, 0);   \
        oo = __builtin_amdgcn_mfma_f32_32x32x16_bf16(pa1, (bf16x8){l1[0], l1[1], l1[2], l1[3], h1[0], h1[1], h1[2], h1[3]}, oo, 0, 0, 0);   \
        oo = __builtin_amdgcn_mfma_f32_32x32x16_bf16(pa2, (bf16x8){l2[0], l2[1], l2[2], l2[3], h2[0], h2[1], h2[2], h2[3]}, oo, 0, 0, 0);   \
        oo = __builtin_amdgcn_mfma_f32_32x32x16_bf16(pa3, (bf16x8){l3[0], l3[1], l3[2], l3[3], h3[0], h3[1], h3[2], h3[3]}, oo, 0, 0, 0); } while (0)
template <int VB>
__device__ __forceinline__ void pv_tile(f32x16* o, int vb0, bf16x8 pa0, bf16x8 pa1, bf16x8 pa2, bf16x8 pa3) {
    PV_D0(VB, 0, o[0]); PV_D0(VB, 1, o[1]); PV_D0(VB, 2, o[2]); PV_D0(VB, 3, o[3]);
}
template <int VB, int DA>
__device__ __forceinline__ void pv_half(f32x16* o2, int vb0, bf16x8 pa0, bf16x8 pa1, bf16x8 pa2, bf16x8 pa3) {
    PV_D0(VB, DA, o2[0]); PV_D0(VB, DA + 1, o2[1]);
}

__device__ __forceinline__ float rowsum16(const float (&sq)[16], int r32) {
    const bool b4 = r32 & 16, b3 = r32 & 8, b2 = r32 & 4, b1 = r32 & 2;
    float t[8], u[4], v[2];
#pragma unroll
    for (int j = 0; j < 8; ++j) { const float mine = b4 ? sq[8 + j] : sq[j], oth = b4 ? sq[j] : sq[8 + j]; t[j] = mine + __shfl_xor(oth, 16); }
#pragma unroll
    for (int j = 0; j < 4; ++j) { const float mine = b3 ? t[4 + j] : t[j], oth = b3 ? t[j] : t[4 + j]; u[j] = mine + __shfl_xor(oth, 8); }
#pragma unroll
    for (int j = 0; j < 2; ++j) { const float mine = b2 ? u[2 + j] : u[j], oth = b2 ? u[j] : u[2 + j]; v[j] = mine + __shfl_xor(oth, 4); }
    const float mine = b1 ? v[1] : v[0], oth = b1 ? v[0] : v[1]; float w = mine + __shfl_xor(oth, 2);
    return w + __shfl_xor(w, 1);
}
struct BlockRef { const bf16* Q; const bf16* K; const bf16* V; bf16* O; const float* NB; float* SS; int P0; };
struct Seam { bf16x8 qr[8]; bf16x8 st0, st1; };
#define VMW() asm volatile("s_waitcnt vmcnt(0)" ::: "memory")
#define VMWN(n) asm volatile("s_waitcnt vmcnt(%0)" :: "i"(n) : "memory")
#define SLOAD2(p, k0) do { const char* b_ = (const char*)(p) + (size_t)(k0) * (D * 2); S.st0 = ldg16(b_, voff); S.st1 = ldg16(b_ + 32 * D * 2, voff); } while (0)
#define SWRITE_K(bf) do { *(bf16x8*)(K_lds + (bf) * SHM_K + kws) = S.st0; *(bf16x8*)(K_lds + (bf) * SHM_K + kws + 32 * 256) = S.st1; } while (0)
#define SWRITE_V(bf) do { *(bf16x8*)(V_lds + (bf) * SHM_V + vst0) = S.st0; *(bf16x8*)(V_lds + (bf) * SHM_V + vst1) = S.st1; } while (0)
__device__ __forceinline__ void bias_to_lds(const float* NB, char* lds, int reg, const int tid) {
    const f32x4 a = *(const f32x4*)(NB + tid * 4), b = *(const f32x4*)(NB + 2048 + tid * 4);
    float* dst = (float*)(lds + OFF_BIAS + reg * BIAS_BYTES);
    *(f32x4*)(dst + tid * 4) = a; *(f32x4*)(dst + 2048 + tid * 4) = b;
}
__device__ __forceinline__ void prime(const BlockRef& cur, char* lds, Seam& S, const int tid) {
    const int wid = __builtin_amdgcn_readfirstlane(tid >> 6), lane = tid & 63, r32 = lane & 31, hi = lane >> 5;
    const int sr = tid >> 4, sc = (tid & 15) * 8, kws = KSWZ(sr, sc * 2); char* K_lds = lds + 2 * SHM_V; const unsigned voff = (unsigned)(sr * D + sc) * 2u;
#pragma unroll
    for (int d0 = 0; d0 < 8; ++d0) S.qr[d0] = load8(cur.Q + (size_t)(wid * QBLK + r32) * D + d0 * 16 + hi * 8);
    const int kb0 = ((cur.P0 + QB - 1) / KVBLK) * KVBLK;
    SLOAD2(cur.K, kb0);
    bias_to_lds(cur.NB, lds, 0, tid);
    VMW(); SWRITE_K(0); SBAR(); SLOAD2(cur.V, kb0);
    __syncthreads();
}
__device__ __forceinline__ void block(const BlockRef& cur, const BlockRef& nxt, char* lds, Seam& S, int par, const int tid) {
    const int wid = __builtin_amdgcn_readfirstlane(tid >> 6), lane = tid & 63, r32 = lane & 31, hi = lane >> 5;
    constexpr int W = SEQ;
    const int NT = (cur.P0 + QB - 1) / KVBLK + 1;
    const int qlo = cur.P0 + wid * QBLK, qm = qlo + r32 - 4 * hi;
    char* V_lds = lds; char* K_lds = lds + 2 * SHM_V;
    float* ws = (float*)(lds + OFF_WS) + wid * 64; float* li_l = ws, * al_l = ws + 32;
    const float* bl = (const float*)(lds + OFF_BIAS + par * BIAS_BYTES) + 4 * hi;
    float m_reg = -1e30f, l_reg = 0; f32x16 o[4] = {};
    const int sr = tid >> 4, sc = (tid & 15) * 8, vst0 = v_st(sr, sc), vst1 = v_st(32 + sr, sc), kws = KSWZ(sr, sc * 2); const unsigned voff = (unsigned)(sr * D + sc) * 2u;
    const int vb0 = (int)(uintptr_t)V_lds + v_rd_base(lane);
    const bf16* Kh = cur.K; const bf16* Vh = cur.V;
#define RESC(a) do { if (__any((a) < 1.f)) { if (hi == 0) al_l[r32] = (a); asm volatile("s_waitcnt lgkmcnt(0)" ::: "memory");              \
                     for (int d_ = 0; d_ < 4; ++d_) for (int r = 0; r < 16; ++r) o[d_][r] *= al_l[crow(r, hi)]; } } while (0)
#define KBASE(t) ((NT - 1 - (t)) * KVBLK)
#define MASKT(P0_, P1_, t) do { const int kb_ = KBASE(t); if (kb_ + KVBLK - 1 > qlo) mask_tile(P0_, P1_, qm - kb_, (unsigned)W); } while (0)
    f32x16 pA0, pA1, pB0, pB1; float mnA, mnB, alA, alB; bf16x8 pa0, pa1, pa2, pa3;
    VMW(); SWRITE_V(0); SBAR();
    SLOAD2(Kh, KBASE(1));
    SBAR(); qkt<0>(pA0, pA1, K_lds, r32, hi, S.qr, bl + KBASE(0));
    VMW(); SWRITE_K(1); SBAR(); SLOAD2(Vh, KBASE(1));
    MASKT(pA0, pA1, 0); partialSM(pA0, pA1, m_reg, mnA, alA);
    VMW(); SWRITE_V(1); SBAR(); if (NT > 2) SLOAD2(Kh, KBASE(2));
    __syncthreads();
#define HALF_STEP(PX0, PX1, mnX, alX, PY0, PY1, alY, t, KB, VB, SB) do {                                                      \
        SBAR(); qkt<KB>(PX0, PX1, K_lds, r32, hi, S.qr, bl + KBASE(t));                                                      \
        finishSM(PY0, PY1, alY, l_reg, pa0, pa1, pa2, pa3); SBAR();                                                           \
        if ((t) + 1 < NT) { VMW(); SWRITE_K(SB); SBAR(); SLOAD2(Vh, KBASE((t) + 1)); SBAR(); }                                \
        pv_tile<VB>(o, vb0, pa0, pa1, pa2, pa3); MASKT(PX0, PX1, (t)); partialSM(PX0, PX1, m_reg, mnX, alX);                  \
        __syncthreads();                                                                                                      \
        if ((t) + 1 < NT) { VMW(); SWRITE_V(SB); SBAR(); if ((t) + 2 < NT) SLOAD2(Kh, KBASE((t) + 2)); }                      \
        RESC(alX); __syncthreads(); } while (0)
    for (int t = 1; t + 1 < NT; t += 2) {
        HALF_STEP(pB0, pB1, mnB, alB, pA0, pA1, alA, t, 1, 0, 0);
        HALF_STEP(pA0, pA1, mnA, alA, pB0, pB1, alB, t + 1, 0, 1, 1);
    }
    SBAR(); qkt<1>(pB0, pB1, K_lds, r32, hi, S.qr, bl + KBASE(NT - 1)); SBAR();
    const int kbn = ((nxt.P0 + QB - 1) / KVBLK) * KVBLK;
    SLOAD2(nxt.K, kbn); SBAR();
#pragma unroll
    for (int d0 = 0; d0 < 8; ++d0) S.qr[d0] = load8(nxt.Q + (size_t)(wid * QBLK + r32) * D + d0 * 16 + hi * 8);
    SBAR();
    finishSM(pA0, pA1, alA, l_reg, pa0, pa1, pa2, pa3); SBAR();
    pv_tile<0>(o, vb0, pa0, pa1, pa2, pa3);
    MASKT(pB0, pB1, NT - 1); partialSM(pB0, pB1, m_reg, mnB, alB); __syncthreads(); RESC(alB);
    finishSM(pB0, pB1, alB, l_reg, pa0, pa1, pa2, pa3); SBAR(); pv_tile<1>(o, vb0, pa0, pa1, pa2, pa3);
    SBAR(); VMWN(8); SWRITE_K(0); SBAR(); SLOAD2(nxt.V, kbn); SBAR();
    if (hi == 0) li_l[r32] = l_reg; asm volatile("s_waitcnt lgkmcnt(0)" ::: "memory");
    float rli[16];
#pragma unroll
    for (int r = 0; r < 16; ++r) rli[r] = __builtin_amdgcn_rcpf(li_l[crow(r, hi)]);
    char* Owb = (char*)(cur.O + (size_t)(wid * QBLK) * OP); char* ssb = (char*)(cur.SS + (size_t)(wid * QBLK) * 8);
    const unsigned olane = (unsigned)((4 * hi) * OP + r32) * 2u, slane = (unsigned)(4 * hi * 8) * 4u;
#pragma unroll
    for (int r = 0; r < 16; ++r) { const int rc = (r & 3) + 8 * (r >> 2); float sq = 0.f;
#pragma unroll
        for (int d0 = 0; d0 < 4; ++d0) { const float v = o[d0][r] * rli[r];
            const float vn = __shfl_xor(v, 1); const unsigned w = cvtpk(v, vn); const float vr = __uint_as_float(w << 16); sq += vr * vr;
            if ((r32 & 1) == 0) *(unsigned*)(Owb + (size_t)(rc * OP + d0 * 32) * 2 + olane) = w; }
        sq += __shfl_xor(sq, 1); sq += __shfl_xor(sq, 2); sq += __shfl_xor(sq, 4); sq += __shfl_xor(sq, 8); sq += __shfl_xor(sq, 16);
        if (r32 == 0) *(float*)(ssb + (size_t)(rc * 8) * 4 + slane) = sq;
        asm volatile("" ::: "memory"); }
    bias_to_lds(nxt.NB, lds, par ^ 1, tid);
    __syncthreads();
#undef RESC
#undef KBASE
#undef MASKT
#undef HALF_STEP
}
}
namespace cg = cooperative_groups;
constexpr int NWAVES = 8;
constexpr int BATCH = 4, SEQ = 4096, DM = 2048, NH = 8, HD = 128, DA = 1024, DG = 1024, DFF = 8192, NIN = 5128, NIN2 = 5120, CHUNK = 128;
constexpr int M = BATCH * SEQ;
constexpr float EPS = 1e-6f;
constexpr size_t MiB = 1u << 20;
constexpr size_t WS_SSA = 1 * MiB, WS_SSG = 2 * MiB;
constexpr size_t WS_LF = 4 * MiB, WS_NB = 5 * MiB, WS_WSB = 6 * MiB, WS_LNST = 8 * MiB;
constexpr size_t WS_W1 = 12 * MiB, WS_WO = 32 * MiB, WS_WF1 = 40 * MiB, WS_X1B = 72 * MiB;
constexpr size_t WS_Y16 = 8 * MiB;
constexpr size_t WS_WF2 = 136 * MiB;
constexpr size_t WS_HID = 168 * MiB;
constexpr size_t WS_XN = 168 * MiB, WS_Q = 232 * MiB, WS_K = 264 * MiB, WS_V = 296 * MiB, WS_U = 328 * MiB, WS_YG = 360 * MiB, WS_ATT = 392 * MiB, WS_GM = 424 * MiB, WS_END = 456 * MiB;
constexpr int LDS_BYTES = 147456;
#define LAS __attribute__((address_space(3)))
typedef unsigned short bf16;
typedef unsigned v4u __attribute__((ext_vector_type(4)));
typedef unsigned v2u __attribute__((ext_vector_type(2)));
typedef float f32x4 __attribute__((ext_vector_type(4)));
typedef float f32x2 __attribute__((ext_vector_type(2)));
typedef short bf16x8 __attribute__((ext_vector_type(8)));
#define LDS_WAIT() asm volatile("s_waitcnt lgkmcnt(0)" ::: "memory")
__device__ __forceinline__ unsigned f2bf(float f) { unsigned u = __builtin_bit_cast(unsigned, f); return (u + 0x7fffu + ((u >> 16) & 1u)) >> 16; }
__device__ __forceinline__ unsigned pk2(float lo, float hi) { return f2bf(lo) | (f2bf(hi) << 16); }
__device__ __forceinline__ float bf_lo(unsigned w) { return __uint_as_float(w << 16); }
__device__ __forceinline__ float bf_hi(unsigned w) { return __uint_as_float(w & 0xffff0000u); }
__device__ __forceinline__ float wave_sum(float v) {
#pragma unroll
    for (int o = 1; o < 64; o <<= 1) v += __shfl_xor(v, o);
    return v;
}
__device__ __forceinline__ void p0_transpose_item(const float* W, int ldw, int K, int nblk, bf16* WT, int row_off, const float* gk, LAS float* scr, int item, int lane) {
    const int kb = item / nblk, nb = item % nblk, k0 = 64 * kb, n0 = 64 * nb;
    const int r = lane >> 4, c = lane & 15;
    f32x4 v[16];
#pragma unroll
    for (int i = 0; i < 16; ++i) v[i] = *(const f32x4*)(W + (size_t)(k0 + 4 * i + r) * ldw + n0 + 4 * c);
#pragma unroll
    for (int i = 0; i < 16; ++i) { const int k = 4 * i + r; f32x4 t = v[i]; if (gk) t = t * gk[k0 + k];
        *(LAS f32x4*)(scr + k * 64 + ((4 * c) ^ (((k >> 3) & 7) << 2))) = t; }
    LDS_WAIT(); asm volatile("" ::: "memory");
    const int nrow = lane >> 3, kc = lane & 7;
#pragma unroll
    for (int j = 0; j < 8; ++j) { const int n = 8 * j + nrow; const LAS float* sp = scr + (8 * kc) * 64 + (n ^ (kc << 2));
        v4u o; o.x = pk2(sp[0 * 64], sp[1 * 64]); o.y = pk2(sp[2 * 64], sp[3 * 64]); o.z = pk2(sp[4 * 64], sp[5 * 64]); o.w = pk2(sp[6 * 64], sp[7 * 64]);
        *(v4u*)(WT + (size_t)(row_off + n0 + n) * K + k0 + 8 * kc) = o; }
    LDS_WAIT(); asm volatile("" ::: "memory");
}

#define XB_TMO      128
#define XB_XCNT(j)  (256  + 64 * (j))
#define XB_XSUB(j)  (1280 + 64 * (j))
#define XB_XGEN(j)  (2304 + 64 * (j))
#define XB_TOP      3328
#define XB_TOPGEN   3392
#define XCD_BAR_WORDS 3456
#define XB_SPIN_CAP (1u << 18)

__device__ __forceinline__ unsigned xb_ld(unsigned* p)              { return __hip_atomic_load(p, __ATOMIC_RELAXED, __HIP_MEMORY_SCOPE_AGENT); }
__device__ __forceinline__ unsigned xb_add(unsigned* p, unsigned v) { return __hip_atomic_fetch_add(p, v, __ATOMIC_RELAXED, __HIP_MEMORY_SCOPE_AGENT); }
__device__ __forceinline__ unsigned xb_xcc_id() { return (unsigned)__builtin_amdgcn_s_getreg((3 << 11) | 20) & 0xFu; }
#define XB_SPIN(cond, bar) do { unsigned _sp = 0; while (cond) { __builtin_amdgcn_s_sleep(1); \
    if ((++_sp & 255u) == 0u) { if (xb_ld(&(bar)[XB_TMO])) break; if (_sp > XB_SPIN_CAP) { atomicAdd(&(bar)[XB_TMO], 1u); break; } } } } while (0)

struct XcdBarrier {
    unsigned* bar; unsigned x;
    volatile LAS unsigned* st;
};

__device__ __forceinline__ XcdBarrier xcd_barrier_post(unsigned* bar, volatile LAS unsigned* st, const int tid) {
    XcdBarrier b; b.bar = bar; b.x = xb_xcc_id(); b.st = st;
    if (tid == 0) (void)xb_add(&bar[XB_XCNT(b.x)], 1u);
    return b;
}
__device__ __forceinline__ void xcd_barrier_complete(unsigned* bar, unsigned x, unsigned& nloc, unsigned& nx) {
    const unsigned G = gridDim.x * gridDim.y * gridDim.z;
    unsigned sum, cnt, mine, sp = 0u;
    for (;;) {
        sum = 0u; cnt = 0u; mine = 0u;
#pragma unroll
        for (unsigned j = 0; j < 16; ++j) { const unsigned c = xb_ld(&bar[XB_XCNT(j)]); sum += c; cnt += (c > 0u) ? 1u : 0u; mine = (j == x) ? c : mine; }
        if (sum == G) break;
        __builtin_amdgcn_s_sleep(1);
        if ((++sp & 255u) == 0u) { if (xb_ld(&bar[XB_TMO])) break; if (sp > XB_SPIN_CAP) { atomicAdd(&bar[XB_TMO], 1u); break; } }
    }
    nloc = mine > 0u ? mine : 1u; nx = cnt > 0u ? cnt : 1u;
}

__device__ __forceinline__ void xcd_barrier(const XcdBarrier& b, const int tid) {
    asm volatile("s_waitcnt vmcnt(0)" ::: "memory");
    __syncthreads();
    if (tid == 0) {
        unsigned* bar = b.bar;
        __builtin_amdgcn_s_waitcnt(0);
        unsigned nloc = b.st[0], nx = b.st[1];
        if (nloc == 0u) { xcd_barrier_complete(bar, b.x, nloc, nx); b.st[0] = nloc; b.st[1] = nx; }
        const unsigned old = xb_add(&bar[XB_XSUB(b.x)], 1u);
        const unsigned gen = old / nloc;
        if (old + 1u == (gen + 1u) * nloc) {
            __builtin_amdgcn_fence(__ATOMIC_RELEASE, "agent");
            asm volatile("s_waitcnt vmcnt(0)" ::: "memory");
            const unsigned og = xb_add(&bar[XB_TOP], 1u);
            const unsigned tg = og / nx;
            if (og + 1u == (tg + 1u) * nx) xb_add(&bar[XB_TOPGEN], 1u);
            else XB_SPIN(xb_ld(&bar[XB_TOPGEN]) == tg, bar);
            __builtin_amdgcn_fence(__ATOMIC_ACQUIRE, "agent");
            xb_add(&bar[XB_XGEN(b.x)], 1u);
            asm volatile("s_waitcnt vmcnt(0)" ::: "memory");
        } else {
            XB_SPIN(xb_ld(&bar[XB_XGEN(b.x)]) == gen, bar);
            __builtin_amdgcn_fence(__ATOMIC_ACQUIRE, "agent");
            asm volatile("s_waitcnt vmcnt(0)" ::: "memory");
        }
    }
    __syncthreads();
}

struct Args { const float* in[15]; float* out; unsigned char* ws; };
__device__ __forceinline__ int lane_id_fresh() { int z = 0; asm volatile("" : "+v"(z)); return __builtin_amdgcn_mbcnt_hi(~0u, __builtin_amdgcn_mbcnt_lo(~0u, z)); }
__device__ __forceinline__ att::BlockRef mk_block_ref(int LL, int ps, const bf16* Qb, const bf16* Kb, const bf16* Vb, bf16* MG, const float* NB, float* SSA) {
    constexpr int NQB = SEQ / 256, NX = NQB / 2;
    const int bh = LL / NX, xx = LL % NX, qb = ps ? NQB - 1 - xx : xx, b = bh / NH, h = bh % NH; att::BlockRef r;
    r.Q = (const att::bf16*)Qb + ((size_t)bh * SEQ + (size_t)qb * 256) * HD; r.K = (const att::bf16*)Kb + (size_t)bh * SEQ * HD; r.V = (const att::bf16*)Vb + (size_t)bh * SEQ * HD;
    const size_t row0 = (size_t)b * SEQ + (size_t)qb * 256;
    r.O = (att::bf16*)MG + row0 * DM + h * HD; r.NB = NB + (size_t)bh * SEQ; r.SS = SSA + row0 * 8 + h; r.P0 = qb * 256; return r;
}

__global__ void __launch_bounds__(NWAVES * 64, 2) mk_fwd(Args args) {
    extern __shared__ __attribute__((aligned(16))) unsigned char lds[];
    cg::grid_group grid = cg::this_grid();
    LAS unsigned char* ldsl = (LAS unsigned char*)lds;
    const int wave = __builtin_amdgcn_readfirstlane((int)threadIdx.x >> 6);
#define FRESH_TID const int lane = lane_id_fresh(), tid = wave * 64 + lane; (void)tid
    const int G = gridDim.x; const int bx = blockIdx.x; const int vcu = (G % 8 == 0) ? (bx % 8) * (G / 8) + bx / 8 : bx;
    volatile LAS unsigned* bst = (volatile LAS unsigned*)(ldsl + 131072 + 64);
    if (threadIdx.x == 0) { bst[0] = 0u; bst[1] = 0u; }
    typedef const __attribute__((address_space(4))) Args* ArgP;
#define SEAM() do { FRESH_TID; xcd_barrier(xbar, tid); } while (0)
    ArgP ap = (ArgP)__builtin_amdgcn_kernarg_segment_ptr();
#define PHASE_ARGS FRESH_TID; ArgP A_ = ap; asm volatile("" : "+s"(A_)); unsigned char* ws = A_->ws; (void)ws
#define INP(i) (A_->in[i])
    const int gw = vcu * NWAVES + wave, NGW = G * NWAVES;
    if (ap->ws == nullptr) { grid.sync(); return; }
    XcdBarrier xbar; { FRESH_TID; xbar = xcd_barrier_post((unsigned*)ap->ws, bst, tid); }

#ifndef REPS
#define REPS 0x1111111111ull
#endif
#define REP(k) for (int rep_ = 0; rep_ < (int)((REPS >> (4 * (k))) & 15); ++rep_)
    REP(0) {
        PHASE_ARGS; const float* x = INP(0); const float* g_mix = INP(1); const float* w_in = INP(2); const float* b_f = INP(3); const float* w_s = INP(6); const float* g_att = INP(8); const float* g_gm = INP(9); const float* w_out = INP(10); const float* g_ffn = INP(11); const float* w_ff1 = INP(12); const float* w_ff2 = INP(13);
        bf16* W1t = (bf16*)(ws + WS_W1); bf16* WOt = (bf16*)(ws + WS_WO); bf16* WF1t = (bf16*)(ws + WS_WF1); bf16* WF2t = (bf16*)(ws + WS_WF2); bf16* WSB = (bf16*)(ws + WS_WSB); bf16* XN = (bf16*)(ws + WS_XN); float* LF = (float*)(ws + WS_LF);
        LAS float* scr = (LAS float*)(ldsl + wave * 16384);
        constexpr int I_A = 32 * 48, I_B = 32 * 32, I_O = 32 * 32, I_1 = 32 * 128, I_2 = 128 * 32, NITEMS = I_A + I_B + I_O + I_1 + I_2;
        for (int it = gw; it < NITEMS; it += NGW) {
            int r = it;
            if (r < I_A) { p0_transpose_item(w_in, NIN, DM, 48, W1t, 0, nullptr, scr, r, lane); continue; } r -= I_A;
            if (r < I_B) { p0_transpose_item(w_in + 3080, NIN, DM, 32, W1t, 3072, nullptr, scr, r, lane); continue; } r -= I_B;
            if (r < I_O) { p0_transpose_item(w_out, DM, DM, 32, WOt, 0, (r / 32) * 64 < DA ? g_att : g_gm - DA, scr, r, lane); continue; } r -= I_O;
            if (r < I_1) { p0_transpose_item(w_ff1, DFF, DM, 128, WF1t, 0, g_ffn, scr, r, lane); continue; } r -= I_1;
            p0_transpose_item(w_ff2, DM, DFF, 32, WF2t, 0, nullptr, scr, r, lane);
        }
        for (int i = bx * 512 + tid; i < 8 * 128 * 128 / 8; i += G * 512) { const int e0 = i * 8, t = (e0 >> 7) & 127, s0 = e0 & 127;
            const f32x4 a = *(const f32x4*)(w_s + e0), b = *(const f32x4*)(w_s + e0 + 4); float v[8] = {a[0], a[1], a[2], a[3], b[0], b[1], b[2], b[3]};
#pragma unroll
            for (int e = 0; e < 8; ++e) if (s0 + e > t) v[e] = 0.f;
            v4u o; o.x = pk2(v[0], v[1]); o.y = pk2(v[2], v[3]); o.z = pk2(v[4], v[5]); o.w = pk2(v[6], v[7]); *(v4u*)(WSB + e0) = o; }
        __syncthreads();
        LAS f32x4* WF = (LAS f32x4*)ldsl;
        for (int k = tid; k < DM; k += 512) { const f32x4 a = *(const f32x4*)(w_in + (size_t)k * NIN + 3072), b = *(const f32x4*)(w_in + (size_t)k * NIN + 3076);
            const int q4 = k >> 2, i = k & 3, j = q4 >> 6, l = q4 & 63; WF[((j * 4 + i) * 2 + 0) * 64 + l] = a; WF[((j * 4 + i) * 2 + 1) * 64 + l] = b; }
        __syncthreads();
        f32x4 gv[8];
#pragma unroll
        for (int j = 0; j < 8; ++j) gv[j] = *((const f32x4*)g_mix + lane + 64 * j);
        f32x4 nx[8];
#pragma unroll
        for (int j = 0; j < 8; ++j) nx[j] = *((const f32x4*)(x + (size_t)gw * DM) + lane + 64 * j);
        for (int m = gw; m < M; m += NGW) {
            asm volatile("" ::: "memory");
            f32x4 v[8]; float s = 0.f;
#pragma unroll
            for (int j = 0; j < 8; ++j) { v[j] = nx[j]; s += (v[j][0] * v[j][0] + v[j][1] * v[j][1]) + (v[j][2] * v[j][2] + v[j][3] * v[j][3]); }
            if (m + NGW < M) {
#pragma unroll
                for (int j = 0; j < 8; ++j) nx[j] = *((const f32x4*)(x + (size_t)(m + NGW) * DM) + lane + 64 * j); }
            const float rs = 1.0f / sqrtf(wave_sum(s) * (1.f / DM) + EPS);
            unsigned long long* o8 = (unsigned long long*)(XN + (size_t)m * DM) + lane;
            float zf[8] = {0.f, 0.f, 0.f, 0.f, 0.f, 0.f, 0.f, 0.f};
#pragma unroll
            for (int j = 0; j < 8; ++j) { v[j] = v[j] * rs * gv[j];
                o8[64 * j] = (unsigned long long)pk2(v[j][0], v[j][1]) | ((unsigned long long)pk2(v[j][2], v[j][3]) << 32);
#pragma unroll
                for (int i = 0; i < 4; ++i) { const f32x4 wa = WF[((j * 4 + i) * 2 + 0) * 64 + lane], wb = WF[((j * 4 + i) * 2 + 1) * 64 + lane]; const float hv = v[j][i];
                    zf[0] += hv * wa[0]; zf[1] += hv * wa[1]; zf[2] += hv * wa[2]; zf[3] += hv * wa[3]; zf[4] += hv * wb[0]; zf[5] += hv * wb[1]; zf[6] += hv * wb[2]; zf[7] += hv * wb[3]; } }
            float mine = 0.f;
#pragma unroll
            for (int h = 0; h < 8; ++h) { const float t = wave_sum(zf[h]); if (lane == h) mine = t; }
            if (lane < 8) { const float a = mine + b_f[lane]; const float lf = fminf(a, 0.f) - log1pf(expf(-fabsf(a)));
                const int b = m / SEQ, sidx = m % SEQ; LF[(size_t)(b * NH + lane) * SEQ + sidx] = lf; }
        }
    }
    SEAM();

    REP(1) if (bx < BATCH * NH && wave == 0) {
        PHASE_ARGS; float* LF = (float*)(ws + WS_LF); float* NB = (float*)(ws + WS_NB);
        const float* src = LF + (size_t)bx * SEQ + lane * 64; float* dst = NB + (size_t)bx * SEQ + lane * 64;
        float tot = 0.f;
#pragma unroll
        for (int i = 0; i < 16; ++i) { const f32x4 a = *(const f32x4*)(src + 4 * i); tot += (a[0] + a[1]) + (a[2] + a[3]); }
        float incl = tot;
#pragma unroll
        for (int o = 1; o < 64; o <<= 1) { const float t = __shfl_up(incl, o); if (lane >= o) incl += t; }
        float run = incl - tot;
        const float c = -11.313708498984761f;
#pragma unroll
        for (int i = 0; i < 16; ++i) { const f32x4 a = *(const f32x4*)(src + 4 * i); f32x4 r; run += a[0]; r[0] = run * c; run += a[1]; r[1] = run * c; run += a[2]; r[2] = run * c; run += a[3]; r[3] = run * c; *(f32x4*)(dst + 4 * i) = r; }
    }
    REP(2) {
        PHASE_ARGS; bf16* XN = (bf16*)(ws + WS_XN); bf16* W1t = (bf16*)(ws + WS_W1); bf16* Qb = (bf16*)(ws + WS_Q); bf16* Kb = (bf16*)(ws + WS_K); bf16* Vb = (bf16*)(ws + WS_V); bf16* Ub = (bf16*)(ws + WS_U); bf16* Yb = (bf16*)(ws + WS_YG); float* LNST = (float*)(ws + WS_LNST);
        pg8::Gemm g{XN, W1t, M, NIN2, DM}; pg8::StaticOrder S; S.init(M, NIN2, G, bx);
        pg8::EpiIn E{Qb, Kb, Vb, Ub, Yb, LNST};
        pg8::gemm_phase<pg8::EpiIn, pg8::StaticOrder, true, true>(ldsl, g, S, E, tid);
    }
    SEAM();

    {
        PHASE_ARGS; const float* ln_g = INP(4); const float* ln_b = INP(5); const float* b_s = INP(7);
        bf16* Qb = (bf16*)(ws + WS_Q); bf16* Kb = (bf16*)(ws + WS_K); bf16* Vb = (bf16*)(ws + WS_V); bf16* Ub = (bf16*)(ws + WS_U); bf16* Yb = (bf16*)(ws + WS_YG); bf16* MG = (bf16*)(ws + WS_XN);
        float* NB = (float*)(ws + WS_NB); float* LNST = (float*)(ws + WS_LNST); bf16* WSB = (bf16*)(ws + WS_WSB); float* SSA = (float*)(ws + WS_SSA); float* SSG = (float*)(ws + WS_SSG);
        char* shm = (char*)lds;
        constexpr int NQB = SEQ / 256, NX = NQB / 2, TOTAL = BATCH * NH * NX;
#ifndef ATT_DUP
#define ATT_DUP 1
#endif
#ifndef SYNC_DUP
#define SYNC_DUP 0
#endif
        for (int sd_ = 0; sd_ < SYNC_DUP; ++sd_) SEAM();
        if (vcu < TOTAL) {
            int L = vcu, pass = 0, par = 0;
#define mkref(LL, ps) mk_block_ref((LL) % TOTAL, (ps), Qb, Kb, Vb, MG, NB, SSA)
            att::BlockRef cur = mkref(L, 0);
            att::Seam S;
            att::prime(cur, shm, S, tid);
            for (;;) {
                const bool more_pass = pass == 0, more_item = L + G < TOTAL * ATT_DUP, last = !more_pass && !more_item;
                int passn = pass + 1, Ln = L;
                if (!more_pass) { passn = 0; Ln = more_item ? L + G : L; }
                const att::BlockRef nxt = last ? cur : mkref(Ln, passn);
                att::block(cur, nxt, shm, S, par, tid);
                if (last) break;
                cur = nxt; pass = passn; L = Ln; par ^= 1;
            }
        }
        __syncthreads();
        REP(4) {
            const int r32 = lane & 31, hi = lane >> 5, rg = wave & 3, dh = wave >> 2;
            float* st = (float*)(shm + att::OFF_WS);
            char* V_lds = shm;
            const int vb0 = (int)(uintptr_t)V_lds + att::v_rd_base(lane);
            const int sr = tid >> 4, sc = (tid & 15) * 8;
#ifndef GM_DUP
#define GM_DUP 1
#endif
            constexpr int NUNITS = (M / CHUNK) * NH * GM_DUP;
            int hprev = -1;
            bf16x8 pw[8];
            v4u yv[4]; f32x4 sv[2]; unsigned uv[16];
            const unsigned ulane = (unsigned)((4 * hi) * DG + 2 * r32) * 2u, olane = (unsigned)((4 * hi) * DM + 2 * r32) * 2u;
#define GM_LOAD_Y(un) do { const int ch_ = ((un) >> 3) % (M / CHUNK), h_ = (un) & 7; const size_t m_ = (size_t)ch_ * CHUNK;                     \
                _Pragma("unroll") for (int q = 0; q < 4; ++q) yv[q] = *(const v4u*)(Yb + (m_ + q * 32 + sr) * DG + h_ * HD + sc);          \
                const f32x4* p_ = (const f32x4*)(LNST + (m_ + (tid >> 2)) * 32) + 2 * (tid & 3); sv[0] = p_[0]; sv[1] = p_[1]; } while (0)
#define GM_LOAD_U(un) do { const int ch_ = ((un) >> 3) % (M / CHUNK), h_ = (un) & 7; const char* ub_ = (const char*)(Ub + ((size_t)ch_ * CHUNK + rg * 32) * DG + h_ * HD + dh * 64);   \
                _Pragma("unroll") for (int r = 0; r < 16; ++r) { const int rc_ = (r & 3) + 8 * (r >> 2); uv[r] = *(const unsigned*)(ub_ + (size_t)(rc_ * DG) * 2 + ulane); } } while (0)
            int unit = vcu;
            if (unit < NUNITS) { GM_LOAD_Y(unit); GM_LOAD_U(unit); }
            for (; unit < NUNITS; unit += G) {
                const int ch = (unit >> 3) % (M / CHUNK), h = unit & 7; const size_t m0 = (size_t)ch * CHUNK;
                if (h != hprev) { hprev = h;
                    const bf16* wrow = WSB + ((size_t)h * CHUNK + rg * 32 + r32) * CHUNK + 8 * hi;
#pragma unroll
                    for (int i = 0; i < 8; ++i) pw[i] = *(const bf16x8*)(wrow + 16 * i); }
                const f32x4 g0 = *(const f32x4*)(ln_g + h * HD + sc), g1 = *(const f32x4*)(ln_g + h * HD + sc + 4), c0 = *(const f32x4*)(ln_b + h * HD + sc), c1 = *(const f32x4*)(ln_b + h * HD + sc + 4);
                { float s1 = (sv[0][0] + sv[0][2]) + (sv[1][0] + sv[1][2]), s2 = (sv[0][1] + sv[0][3]) + (sv[1][1] + sv[1][3]);
                  s1 += __shfl_xor(s1, 1); s1 += __shfl_xor(s1, 2); s2 += __shfl_xor(s2, 1); s2 += __shfl_xor(s2, 2);
                  if ((tid & 3) == 0) { const float mu = s1 * (1.f / DG), var = fmaxf(s2 * (1.f / DG) - mu * mu, 0.f); st[2 * (tid >> 2)] = mu; st[2 * (tid >> 2) + 1] = 1.0f / sqrtf(var + EPS); } }
                __syncthreads();
                { const int cpos = ((sc >> 6) * 2) * 32 + ((sc & 63) >> 1);
#pragma unroll
                  for (int q = 0; q < 4; ++q) { const int key = q * 32 + sr;
                    const v4u w = yv[q]; const float mu = st[2 * key], rsd = st[2 * key + 1];
                    const float e0 = (bf_lo(w.x) - mu) * rsd * g0[0] + c0[0], e1 = (bf_hi(w.x) - mu) * rsd * g0[1] + c0[1], e2 = (bf_lo(w.y) - mu) * rsd * g0[2] + c0[2], e3 = (bf_hi(w.y) - mu) * rsd * g0[3] + c0[3];
                    const float e4 = (bf_lo(w.z) - mu) * rsd * g1[0] + c1[0], e5 = (bf_hi(w.z) - mu) * rsd * g1[1] + c1[1], e6 = (bf_lo(w.w) - mu) * rsd * g1[2] + c1[2], e7 = (bf_hi(w.w) - mu) * rsd * g1[3] + c1[3];
                    char* vt = V_lds + (q >> 1) * att::SHM_V; const int krow = (q & 1) * 32 + sr;
                    *(v2u*)(vt + att::v_st(krow, cpos)) = (v2u){pk2(e0, e2), pk2(e4, e6)};
                    *(v2u*)(vt + att::v_st(krow, cpos + 32)) = (v2u){pk2(e1, e3), pk2(e5, e7)}; } }
                att::f32x16 o2[2];
                { const char* bb = (const char*)(b_s + h * CHUNK + rg * 32);
#pragma unroll
                  for (int g = 0; g < 4; ++g) { const f32x4 bv = *(const f32x4*)(bb + (size_t)(8 * g) * 4 + (unsigned)(4 * hi) * 4u);
#pragma unroll
                      for (int i = 0; i < 4; ++i) { o2[0][4 * g + i] = bv[i]; o2[1][4 * g + i] = bv[i]; } } }
                __syncthreads();
                const int nu = unit + G;
                if (nu < NUNITS) GM_LOAD_Y(nu);
                if (dh == 0) att::pv_half<0, 0>(o2, vb0, pw[0], pw[1], pw[2], pw[3]); else att::pv_half<0, 2>(o2, vb0, pw[0], pw[1], pw[2], pw[3]);
                if (rg >= 2) { if (dh == 0) att::pv_half<1, 0>(o2, vb0, pw[4], pw[5], pw[6], pw[7]); else att::pv_half<1, 2>(o2, vb0, pw[4], pw[5], pw[6], pw[7]); }
                char* ob = (char*)(MG + (m0 + rg * 32) * DM + DA + h * HD + dh * 64); char* sb = (char*)(SSG + (m0 + rg * 32) * 16 + h * 2 + dh);
                float sqv[16];
#pragma unroll
                for (int r = 0; r < 16; ++r) { const int rc = (r & 3) + 8 * (r >> 2);
                    const float v0 = bf_lo(uv[r]) * o2[0][r], v1 = bf_hi(uv[r]) * o2[1][r];
                    const unsigned w = att::cvtpk(v0, v1); const float r0 = bf_lo(w), r1 = bf_hi(w); sqv[r] = r0 * r0 + r1 * r1;
                    *(unsigned*)(ob + (size_t)(rc * DM) * 2 + olane) = w; }
                if (nu < NUNITS) GM_LOAD_U(nu);
                { const float tot = att::rowsum16(sqv, r32); const int rr = r32 >> 1;
                  if ((r32 & 1) == 0) *(float*)(sb + (size_t)(((rr & 3) + 8 * (rr >> 2)) * 16) * 4 + (unsigned)(4 * hi * 16) * 4u) = tot; }
                __syncthreads();
            }
#undef GM_LOAD_Y
#undef GM_LOAD_U
        }
    }
    SEAM();

    REP(6) {
        PHASE_ARGS; const float* x = INP(0); bf16* XN = (bf16*)(ws + WS_XN); bf16* WOt = (bf16*)(ws + WS_WO); bf16* X1B = (bf16*)(ws + WS_X1B); const float* SSA = (const float*)(ws + WS_SSA); const float* SSG = (const float*)(ws + WS_SSG);
        pg8::Gemm g{XN, WOt, M, DM, DM}; pg8::StaticOrder S; S.init(M, DM, G, bx);
        LAS f32x2* tab = (LAS f32x2*)(ldsl + 131072 + 256);
        { pg8::Unit uu; int nun = 0; while (nun < 7 && S.next(nun, uu)) ++nun;
          for (int idx = tid; idx < nun * 256; idx += 512) { S.next(idx >> 8, uu); const size_t row = (size_t)uu.pm * 256 + (idx & 255);
              const f32x4 a0 = *(const f32x4*)(SSA + row * 8), a1 = *(const f32x4*)(SSA + row * 8 + 4);
              const f32x4 q0 = *(const f32x4*)(SSG + row * 16), q1 = *(const f32x4*)(SSG + row * 16 + 4), q2 = *(const f32x4*)(SSG + row * 16 + 8), q3 = *(const f32x4*)(SSG + row * 16 + 12);
              const float sa = ((a0[0] + a0[1]) + (a0[2] + a0[3])) + ((a1[0] + a1[1]) + (a1[2] + a1[3]));
              const float sg = (((q0[0] + q0[1]) + (q0[2] + q0[3])) + ((q1[0] + q1[1]) + (q1[2] + q1[3]))) + (((q2[0] + q2[1]) + (q2[2] + q2[3])) + ((q3[0] + q3[1]) + (q3[2] + q3[3])));
              const float rsa = 1.0f / sqrtf(sa * (1.f / 1024.f) + EPS), rsg = 1.0f / sqrtf(sg * (1.f / 1024.f) + EPS);
              tab[idx] = (f32x2){rsa / rsg, rsg}; }
          __syncthreads(); }
        pg8::EpiRes E{x, X1B, tab};
        pg8::gemm_phase<pg8::EpiRes, pg8::StaticOrder, true, true>(ldsl, g, S, E, tid);
    }
    SEAM();

    REP(7) {
        PHASE_ARGS; bf16* X1B = (bf16*)(ws + WS_X1B); bf16* WF1t = (bf16*)(ws + WS_WF1); bf16* HID = (bf16*)(ws + WS_HID);
        pg8::Gemm g{X1B, WF1t, M, DFF, DM}; pg8::StaticOrder S; S.init(M, DFF, G, bx);
        pg8::EpiRelu2 E{HID, DFF};
        pg8::gemm_phase<pg8::EpiRelu2, pg8::StaticOrder, true, true>(ldsl, g, S, E, tid);
    }
    SEAM();

    REP(8) {
        PHASE_ARGS; bf16* HID = (bf16*)(ws + WS_HID); bf16* WF2t = (bf16*)(ws + WS_WF2); bf16* Y16 = (bf16*)(ws + WS_Y16);
        pg8::Gemm g{HID, WF2t, M, DM, DFF}; pg8::StaticOrder S; S.init(M, DM, G, bx);
        pg8::EpiY16 E{Y16};
        pg8::gemm_phase<pg8::EpiY16, pg8::StaticOrder, true, true>(ldsl, g, S, E, tid);
    }
    SEAM();

    REP(9) {
        PHASE_ARGS; const float* g_fin = INP(14); const bf16* X1B = (const bf16*)(ws + WS_X1B); const bf16* Y16 = (const bf16*)(ws + WS_Y16); float* OUT = A_->out;
        for (int m = gw; m < M; m += NGW) {
            const v2u* xr = (const v2u*)(X1B + (size_t)m * DM) + lane; const v2u* yr = (const v2u*)(Y16 + (size_t)m * DM) + lane;
            f32x4 v[8], y[8]; float s = 0.f;
#pragma unroll
            for (int j = 0; j < 8; ++j) { const v2u w = xr[64 * j], wy = yr[64 * j]; y[j] = (f32x4){bf_lo(wy.x), bf_hi(wy.x), bf_lo(wy.y), bf_hi(wy.y)}; v[j] = (f32x4){bf_lo(w.x), bf_hi(w.x), bf_lo(w.y), bf_hi(w.y)}; s += (v[j][0] * v[j][0] + v[j][1] * v[j][1]) + (v[j][2] * v[j][2] + v[j][3] * v[j][3]); }
            const float r1 = 1.0f / (wave_sum(s) * (1.f / DM) + EPS);
            float s2 = 0.f;
#pragma unroll
            for (int j = 0; j < 8; ++j) { v[j] = v[j] + y[j] * r1; s2 += (v[j][0] * v[j][0] + v[j][1] * v[j][1]) + (v[j][2] * v[j][2] + v[j][3] * v[j][3]); }
            const float r2 = 1.0f / sqrtf(wave_sum(s2) * (1.f / DM) + EPS);
            f32x4* orow = (f32x4*)(OUT + (size_t)m * DM) + lane;
#pragma unroll
            for (int j = 0; j < 8; ++j) orow[64 * j] = v[j] * r2 * *((const f32x4*)g_fin + lane + 64 * j);
        }
    }
}

extern "C" void kernel_launch(void* const* d_in, const int* in_sizes, int n_in, void* d_out, int out_size, void* d_ws, size_t ws_size, hipStream_t stream) {
    static int grid = 0;
    if (grid == 0) {
        if (n_in != 15 || in_sizes[0] != M * DM || out_size != M * DM || ws_size < WS_END) { fprintf(stderr, "kernel_launch: shape/workspace mismatch (n_in %d, in0 %d, out %d, ws %zu < %zu)\n", n_in, n_in > 0 ? in_sizes[0] : -1, out_size, ws_size, (size_t)WS_END); grid = -1; return; }
        int dev = 0, cus = 0, per_cu = 0;
        hipGetDevice(&dev); hipDeviceGetAttribute(&cus, hipDeviceAttributeMultiprocessorCount, dev);
        if (hipFuncSetAttribute((const void*)mk_fwd, hipFuncAttributeMaxDynamicSharedMemorySize, LDS_BYTES) != hipSuccess) { fprintf(stderr, "kernel_launch: hipFuncSetAttribute failed\n"); grid = -1; return; }
        if (hipOccupancyMaxActiveBlocksPerMultiprocessor(&per_cu, (const void*)mk_fwd, NWAVES * 64, LDS_BYTES) != hipSuccess || per_cu < 1) { fprintf(stderr, "kernel_launch: occupancy query says %d\n", per_cu); per_cu = 1; }
        (void)hipGetLastError();
        grid = cus * per_cu;
    }
    if (grid < 0) return;
    if (hipMemsetAsync(d_ws, 0, 16384, stream) != hipSuccess) { fprintf(stderr, "kernel_launch: hipMemsetAsync of the barrier words failed\n"); return; }
    Args a{};
    for (int i = 0; i < 15; ++i) a.in[i] = (const float*)d_in[i];
    a.out = (float*)d_out; a.ws = (unsigned char*)d_ws;
    void* kargs[] = {&a};
    hipError_t e = hipLaunchCooperativeKernel((const void*)mk_fwd, dim3(grid), dim3(NWAVES * 64), kargs, LDS_BYTES, stream);
    if (e != hipSuccess) fprintf(stderr, "cooperative launch failed: %s (grid %d)\n", hipGetErrorString(e), grid);
}
```

```cpp
#include <hip/hip_runtime.h>
#include <hip/hip_cooperative_groups.h>
#include <hip/hip_bf16.h>
#include <cstdio>
#include <cstdint>
#include <cmath>
namespace pg8 {
#define PG8_LAS __attribute__((address_space(3)))
typedef unsigned short bf16_t;
typedef short bf16x8 __attribute__((ext_vector_type(8)));
typedef float f32x4 __attribute__((ext_vector_type(4)));
typedef unsigned u32x4 __attribute__((ext_vector_type(4)));
constexpr int BM = 256, BK = 64, HALF = 128, HTB = HALF * BK * 2  , STAGE_BYTES = 8 * HTB, NXCD = 8, WGM = 8;

__host__ __device__ __forceinline__ int lds_byte(int r, int c) { const int st = (r >> 4) * 2 + (c >> 5), rr = r & 15, cc = c & 31, ob = rr * 64 + cc * 2; return st * 1024 + (ob ^ (((ob >> 9) & 1) << 5)); }
__host__ __device__ __forceinline__ void stage_rc(int b, int& R, int& C) { const int st = b / 1024, sb = b % 1024, swz = sb ^ (((sb >> 9) & 1) << 5); R = (st >> 1) * 16 + swz / 64; C = (st & 1) * 32 + (swz % 64) / 2; }
__host__ __device__ __forceinline__ int perm32(int rho) { const int n = rho >> 4, i = rho & 15; return 8 * (i >> 2) + 4 * n + (i & 3); }

struct Unit { int pm, pn; };
struct Gemm { const bf16_t* A; const bf16_t* Bt; int M, N, K; };

struct StaticOrder {
    int nM, nN, nwg, G, c;
    __host__ __device__ void init(int M, int N, int G_, int c_) { nM = M / BM; nN = N / BM; nwg = nM * nN; G = G_; c = c_; }
    __host__ __device__ bool next(int i, Unit& u) const {
        const long L = (long)i * G + c; if (L >= nwg) return false;
        int wgid = (int)L; { const int q = nwg / NXCD, r = nwg % NXCD, xcd = wgid % NXCD, off = wgid / NXCD; wgid = (xcd < r ? xcd * (q + 1) : r * (q + 1) + (xcd - r) * q) + off; }
        const int nig = WGM * nN, gid = wgid / nig, fm = gid * WGM, gsz = (nM - fm) < WGM ? (nM - fm) : WGM;
        u.pm = fm + ((wgid % nig) % gsz); u.pn = (wgid % nig) / gsz; return true;
    }
    __device__ __forceinline__ void a_ready(const Unit&) const {}
    __device__ __forceinline__ void done(const Unit&) const {}
};

__device__ __forceinline__ unsigned cvt_pk_bf16(float lo, float hi) { unsigned r; asm volatile("v_cvt_pk_bf16_f32 %0, %1, %2" : "=v"(r) : "v"(lo), "v"(hi)); return r; }
typedef float f32x2 __attribute__((ext_vector_type(2)));
typedef unsigned u32x2 __attribute__((ext_vector_type(2)));
__device__ __forceinline__ float gelu_tanh(float v) {
    const float t = v * (1.0f + 0.044715f * v * v);
    const float e = __builtin_amdgcn_exp2f(-2.302208198f * t);
    return v * __builtin_amdgcn_rcpf(1.0f + e);
}
constexpr int SEQ_ = 4096, NH_ = 8;
struct EpiIn {
    static constexpr bool PERM = true, AFTER_DRAIN = false, MIDHOOK = false;
    bf16_t* Q; bf16_t* Kk; bf16_t* V; bf16_t* U; bf16_t* Y; float* lnst;
    __device__ __forceinline__ void operator()(const f32x4 (&acc)[2][2][4][2], const Unit& u, int wr, int wc, int fr, int fq) const {
        const int grp = u.pn >> 2, sub = u.pn & 3;
        const int row0 = u.pm * BM + wr * 64 + fr;
        if (grp < 3) {
            bf16_t* base = Q + (size_t)grp * (size_t)(16u << 20);
#pragma unroll
            for (int ai = 0; ai < 2; ++ai)
#pragma unroll
                for (int m = 0; m < 4; ++m) { const int row = row0 + ai * HALF + m * 16; const int b = row / SEQ_, s = row % SEQ_;
#pragma unroll
                    for (int bj = 0; bj < 2; ++bj) { const int head = sub * 2 + bj;
                        bf16_t* p = base + ((size_t)(b * NH_ + head) * SEQ_ + s) * 128 + wc * 32 + 8 * fq;
                        const f32x4 v0 = acc[ai][bj][m][0], v1 = acc[ai][bj][m][1];
                        u32x4 w; w.x = cvt_pk_bf16(v0[0], v0[1]); w.y = cvt_pk_bf16(v0[2], v0[3]); w.z = cvt_pk_bf16(v1[0], v1[1]); w.w = cvt_pk_bf16(v1[2], v1[3]);
                        *(u32x4*)p = w; } }
        } else {
            bf16_t* base = Q + (size_t)grp * (size_t)(16u << 20);
#pragma unroll
            for (int ai = 0; ai < 2; ++ai)
#pragma unroll
                for (int m = 0; m < 4; ++m) { const int row = row0 + ai * HALF + m * 16;
                    bf16_t* rowp = base + (size_t)row * 1024 + sub * 256 + wc * 32 + 8 * fq;
                    float s1 = 0.f, s2 = 0.f;
#pragma unroll
                    for (int bj = 0; bj < 2; ++bj) { const f32x4 v0 = acc[ai][bj][m][0], v1 = acc[ai][bj][m][1];
                        u32x4 w; w.x = cvt_pk_bf16(gelu_tanh(v0[0]), gelu_tanh(v0[1])); w.y = cvt_pk_bf16(gelu_tanh(v0[2]), gelu_tanh(v0[3]));
                        w.z = cvt_pk_bf16(gelu_tanh(v1[0]), gelu_tanh(v1[1])); w.w = cvt_pk_bf16(gelu_tanh(v1[2]), gelu_tanh(v1[3]));
                        *(u32x4*)(rowp + bj * HALF) = w;
                        if (grp == 4) {
#pragma unroll
                            for (int e = 0; e < 4; ++e) { const float lo = __uint_as_float(w[e] << 16), hi = __uint_as_float(w[e] & 0xffff0000u); s1 += lo + hi; s2 += lo * lo + hi * hi; } } }
                    if (grp == 4) { s1 += __shfl_xor(s1, 16); s1 += __shfl_xor(s1, 32); s2 += __shfl_xor(s2, 16); s2 += __shfl_xor(s2, 32);
                        if (fq == 0) *(f32x2*)(lnst + ((size_t)row * 16 + sub * 4 + wc) * 2) = (f32x2){s1, s2}; } }
        }
    }
};
struct EpiRes {
    static constexpr bool PERM = true, AFTER_DRAIN = false, MIDHOOK = true;
    const float* X; bf16_t* X1b; const PG8_LAS f32x2* tab;
    __device__ __forceinline__ void mid(f32x4 (&acc)[2][2][4][2], int ui, int wr, int fr) const {
#pragma unroll
        for (int ai = 0; ai < 2; ++ai)
#pragma unroll
            for (int m = 0; m < 4; ++m) { const float ratio = tab[ui * BM + ai * HALF + wr * 64 + m * 16 + fr].x;
#pragma unroll
                for (int bj = 0; bj < 2; ++bj)
#pragma unroll
                    for (int n = 0; n < 2; ++n) acc[ai][bj][m][n] = acc[ai][bj][m][n] * ratio; }
    }
    __device__ __forceinline__ void operator()(const f32x4 (&acc)[2][2][4][2], const Unit& u, int ui, int wr, int wc, int fr, int fq) const {
        const int row0 = u.pm * BM + wr * 64 + fr, col0 = u.pn * BM + wc * 32 + 8 * fq;
#pragma unroll
        for (int ai = 0; ai < 2; ++ai)
#pragma unroll
            for (int m = 0; m < 4; ++m) { const size_t off = (size_t)(row0 + ai * HALF + m * 16) * 2048 + col0; const float rsg = tab[ui * BM + ai * HALF + wr * 64 + m * 16 + fr].y;
#pragma unroll
                for (int bj = 0; bj < 2; ++bj) { const f32x4 o0 = *(const f32x4*)(X + off + bj * HALF) + acc[ai][bj][m][0] * rsg, o1 = *(const f32x4*)(X + off + bj * HALF + 4) + acc[ai][bj][m][1] * rsg;
                    u32x4 w; w.x = cvt_pk_bf16(o0[0], o0[1]); w.y = cvt_pk_bf16(o0[2], o0[3]); w.z = cvt_pk_bf16(o1[0], o1[1]); w.w = cvt_pk_bf16(o1[2], o1[3]);
                    *(u32x4*)(X1b + off + bj * HALF) = w; } }
    }
};
struct EpiRelu2 {
    static constexpr bool PERM = true, AFTER_DRAIN = false, MIDHOOK = false;
    bf16_t* O; int ldc;
    __device__ __forceinline__ void operator()(const f32x4 (&acc)[2][2][4][2], const Unit& u, int wr, int wc, int fr, int fq) const {
        const int row0 = u.pm * BM + wr * 64 + fr, col0 = u.pn * BM + wc * 32 + 8 * fq;
#pragma unroll
        for (int ai = 0; ai < 2; ++ai)
#pragma unroll
            for (int m = 0; m < 4; ++m) { bf16_t* rowp = O + (size_t)(row0 + ai * HALF + m * 16) * ldc + col0;
#pragma unroll
                for (int bj = 0; bj < 2; ++bj) { f32x4 v0 = acc[ai][bj][m][0], v1 = acc[ai][bj][m][1];
#pragma unroll
                    for (int e = 0; e < 4; ++e) { const float a = fmaxf(v0[e], 0.f), b = fmaxf(v1[e], 0.f); v0[e] = a * a; v1[e] = b * b; }
                    u32x4 w; w.x = cvt_pk_bf16(v0[0], v0[1]); w.y = cvt_pk_bf16(v0[2], v0[3]); w.z = cvt_pk_bf16(v1[0], v1[1]); w.w = cvt_pk_bf16(v1[2], v1[3]);
                    *(u32x4*)(rowp + bj * HALF) = w; } }
    }
};
struct EpiY16 {
    static constexpr bool PERM = true, AFTER_DRAIN = false, MIDHOOK = false;
    bf16_t* Yo;
    __device__ __forceinline__ void operator()(const f32x4 (&acc)[2][2][4][2], const Unit& u, int wr, int wc, int fr, int fq) const {
        const int row0 = u.pm * BM + wr * 64 + fr, col0 = u.pn * BM + wc * 32 + 8 * fq;
#pragma unroll
        for (int ai = 0; ai < 2; ++ai)
#pragma unroll
            for (int m = 0; m < 4; ++m) { bf16_t* rowp = Yo + (size_t)(row0 + ai * HALF + m * 16) * 2048 + col0;
#pragma unroll
                for (int bj = 0; bj < 2; ++bj) { const f32x4 v0 = acc[ai][bj][m][0], v1 = acc[ai][bj][m][1];
                    u32x4 w; w.x = cvt_pk_bf16(v0[0], v0[1]); w.y = cvt_pk_bf16(v0[2], v0[3]); w.z = cvt_pk_bf16(v1[0], v1[1]); w.w = cvt_pk_bf16(v1[2], v1[3]);
                    *(u32x4*)(rowp + bj * HALF) = w; } }
    }
};

template <class Epi, class Sched, bool ALIGN_EPI = false, bool SP2 = false>
__device__ __forceinline__ void gemm_phase(PG8_LAS unsigned char* lds, const Gemm g, const Sched& S, const Epi& E, const int tid) {
    const int wid = __builtin_amdgcn_readfirstlane(tid >> 6), lane = tid & 63, wr = wid >> 2, wc = wid & 3, fr = lane & 15, fq = lane >> 4;
    const int K = g.K, nt = K / BK;
    unsigned voffA[2], voffB[2];
#pragma unroll
    for (int i = 0; i < 2; ++i) { int R, C; stage_rc(tid * 16 + i * 8192, R, C); const int Rb = Epi::PERM ? ((R & ~31) + perm32(R & 31)) : R;
        voffA[i] = (unsigned)(R * K + C) * 2u; voffB[i] = (unsigned)(Rb * K + C) * 2u; }
    const size_t kstep = (size_t)(BK * 2);
    const size_t hstep = (size_t)HALF * K * 2;
    const size_t tstep = 2 * hstep;
    const unsigned ldsw = (unsigned)wid * 1024u;
    const int aoff = lds_byte(wr * 64 + fr, fq * 8), boff = lds_byte(wc * 32 + fr, fq * 8);
#define PG8_SA(b, h) (((b) * 2 + (h)) * HTB)
#define PG8_SB(b, h) ((4 + (b) * 2 + (h)) * HTB)
#define PG8_STAGE(bufoff, gbase, voff) do { _Pragma("unroll") for (int _i = 0; _i < 2; ++_i) \
        __builtin_amdgcn_global_load_lds((const unsigned*)((const char*)(gbase) + (voff)[_i]), (PG8_LAS unsigned*)(lds + (bufoff) + ldsw + _i * 8192), 16, 0, 0); } while (0)
#define PG8_LDA(dst, b, h) do { _Pragma("unroll") for (int m = 0; m < 4; ++m) _Pragma("unroll") for (int k = 0; k < 2; ++k) dst[m][k] = *(const PG8_LAS bf16x8*)(lds + PG8_SA(b, h) + aoff + m * 2048 + k * 1024); } while (0)
#define PG8_LDB(dst, b, h) do { _Pragma("unroll") for (int n = 0; n < 2; ++n) _Pragma("unroll") for (int k = 0; k < 2; ++k) dst[n][k] = *(const PG8_LAS bf16x8*)(lds + PG8_SB(b, h) + boff + n * 2048 + k * 1024); } while (0)
#define PG8_MMA(ai, bj, At, Bt) do { __builtin_amdgcn_s_setprio(1); _Pragma("unroll") for (int m = 0; m < 4; ++m) _Pragma("unroll") for (int n = 0; n < 2; ++n) _Pragma("unroll") for (int k = 0; k < 2; ++k) \
        acc[ai][bj][m][n] = __builtin_amdgcn_mfma_f32_16x16x32_bf16(Bt[n][k], At[m][k], acc[ai][bj][m][n], 0, 0, 0); __builtin_amdgcn_s_setprio(0); } while (0)
#define PG8_WAIT_V(n) asm volatile("s_waitcnt vmcnt(" #n ")" ::: "memory")
#define PG8_WAIT_L(n) asm volatile("s_waitcnt lgkmcnt(" #n ")" ::: "memory")
#define PG8_BAR __builtin_amdgcn_s_barrier()
#define PG8_SCHED __builtin_amdgcn_sched_barrier(0)
    Unit cur, nxt; int ui = 0;
    if (!S.next(0, cur)) return;
    f32x4 acc[2][2][4][2];
#pragma unroll
    for (int a = 0; a < 2; ++a)
#pragma unroll
        for (int b = 0; b < 2; ++b)
#pragma unroll
            for (int m = 0; m < 4; ++m)
#pragma unroll
                for (int n = 0; n < 2; ++n) acc[a][b][m][n] = (f32x4){0.f, 0.f, 0.f, 0.f};
    bf16x8 At[4][2], B0[2][2], B1[2][2];
    const char* cA = (const char*)g.A + (size_t)cur.pm * tstep; const char* cB = (const char*)g.Bt + (size_t)cur.pn * tstep;
    S.a_ready(cur);
    if constexpr (SP2) {
        PG8_STAGE(PG8_SB(0, 0), cB, voffB); PG8_STAGE(PG8_SB(0, 1), cB + hstep, voffB); PG8_STAGE(PG8_SA(0, 0), cA, voffA); PG8_STAGE(PG8_SA(0, 1), cA + hstep, voffA);
        if (wr == 1) PG8_BAR;
        PG8_WAIT_V(2); PG8_BAR;
        PG8_STAGE(PG8_SB(1, 0), cB + kstep, voffB); PG8_STAGE(PG8_SA(1, 0), cA + kstep, voffA); PG8_STAGE(PG8_SB(1, 1), cB + hstep + kstep, voffB);
        PG8_WAIT_V(6); PG8_BAR;
    } else {
        PG8_STAGE(PG8_SB(0, 0), cB, voffB); PG8_STAGE(PG8_SA(0, 0), cA, voffA); PG8_STAGE(PG8_SB(0, 1), cB + hstep, voffB); PG8_STAGE(PG8_SA(0, 1), cA + hstep, voffA);
        if (wr == 1) PG8_BAR;
        PG8_WAIT_V(4); PG8_BAR;
        PG8_STAGE(PG8_SB(1, 0), cB + kstep, voffB); PG8_STAGE(PG8_SA(1, 0), cA + kstep, voffA); PG8_STAGE(PG8_SB(1, 1), cB + hstep + kstep, voffB);
        PG8_WAIT_V(6); PG8_BAR;
    }
    for (;;) {
        const bool has_next = S.next(ui + 1, nxt);
        const char* nA = has_next ? (const char*)g.A + (size_t)nxt.pm * tstep : cA; const char* nB = has_next ? (const char*)g.Bt + (size_t)nxt.pn * tstep : cB;
        for (int t = 0; t < nt; t += 2) {
            if constexpr (Epi::MIDHOOK) { if (t == (nt >> 1)) E.mid(acc, ui, wr, fr); }
            const bool last = (t == nt - 2);
            const char* a1 = cA + (size_t)(t + 1) * kstep;
            const char* a2 = last ? nA : cA + (size_t)(t + 2) * kstep; const char* b2 = last ? nB : cB + (size_t)(t + 2) * kstep;
            const char* a3 = a2 + kstep; const char* b3 = b2 + kstep;
            if (last && has_next) S.a_ready(nxt);
            if constexpr (SP2) {
            PG8_LDB(B0, 0, 0); PG8_LDB(B1, 0, 1); PG8_SCHED; PG8_LDA(At, 0, 0); PG8_STAGE(PG8_SA(1, 1), a1 + hstep, voffA);
            PG8_WAIT_V(8); PG8_WAIT_L(0); PG8_BAR; PG8_MMA(0, 0, At, B0); PG8_MMA(0, 1, At, B1); PG8_BAR; PG8_SCHED;
            PG8_LDA(At, 0, 1); PG8_STAGE(PG8_SB(0, 0), b2, voffB); PG8_STAGE(PG8_SB(0, 1), b2 + hstep, voffB); PG8_STAGE(PG8_SA(0, 0), a2, voffA);
            PG8_WAIT_V(8); PG8_WAIT_L(0); PG8_BAR; PG8_MMA(1, 0, At, B0); PG8_MMA(1, 1, At, B1); PG8_BAR; PG8_SCHED;
            PG8_LDB(B0, 1, 0); PG8_LDB(B1, 1, 1); PG8_SCHED; PG8_LDA(At, 1, 0); PG8_STAGE(PG8_SA(0, 1), a2 + hstep, voffA);
            PG8_WAIT_V(8); PG8_WAIT_L(0); PG8_BAR; PG8_MMA(0, 0, At, B0); PG8_MMA(0, 1, At, B1); PG8_BAR; PG8_SCHED;
            PG8_LDA(At, 1, 1); PG8_STAGE(PG8_SB(1, 0), b3, voffB); PG8_STAGE(PG8_SB(1, 1), b3 + hstep, voffB); PG8_STAGE(PG8_SA(1, 0), a3, voffA);
            PG8_WAIT_V(8); PG8_WAIT_L(0); PG8_BAR; PG8_MMA(1, 0, At, B0); PG8_MMA(1, 1, At, B1); PG8_BAR; PG8_SCHED;
            } else {
            PG8_LDB(B0, 0, 0); PG8_SCHED; PG8_LDA(At, 0, 0); PG8_STAGE(PG8_SA(1, 1), a1 + hstep, voffA);
            PG8_WAIT_L(8); PG8_BAR; PG8_WAIT_L(0); PG8_MMA(0, 0, At, B0); PG8_BAR; PG8_SCHED;
            PG8_LDB(B1, 0, 1); PG8_STAGE(PG8_SB(0, 0), b2, voffB);
            PG8_BAR; PG8_WAIT_L(0); PG8_MMA(0, 1, At, B1); PG8_BAR;
            PG8_LDA(At, 0, 1); PG8_STAGE(PG8_SA(0, 0), a2, voffA);
            PG8_BAR; PG8_WAIT_L(0); PG8_MMA(1, 0, At, B0); PG8_BAR; PG8_SCHED;
            PG8_STAGE(PG8_SB(0, 1), b2 + hstep, voffB);
            PG8_WAIT_V(6); PG8_BAR; PG8_MMA(1, 1, At, B1); PG8_BAR;
            PG8_LDB(B0, 1, 0); PG8_SCHED; PG8_LDA(At, 1, 0); PG8_STAGE(PG8_SA(0, 1), a2 + hstep, voffA);
            PG8_WAIT_L(8); PG8_BAR; PG8_WAIT_L(0); PG8_MMA(0, 0, At, B0); PG8_BAR; PG8_SCHED;
            PG8_LDB(B1, 1, 1); PG8_STAGE(PG8_SB(1, 0), b3, voffB);
            PG8_BAR; PG8_WAIT_L(0); PG8_MMA(0, 1, At, B1); PG8_BAR;
            PG8_LDA(At, 1, 1); PG8_STAGE(PG8_SA(1, 0), a3, voffA);
            PG8_BAR; PG8_WAIT_L(0); PG8_MMA(1, 0, At, B0); PG8_BAR; PG8_SCHED;
            PG8_STAGE(PG8_SB(1, 1), b3 + hstep, voffB);
            PG8_WAIT_V(6); PG8_BAR; PG8_MMA(1, 1, At, B1); PG8_BAR;
            }
        }
        if constexpr (ALIGN_EPI) { if (wr == 0) PG8_BAR; }
        if constexpr (!Epi::AFTER_DRAIN) { if constexpr (Epi::MIDHOOK) E(acc, cur, ui, wr, wc, fr, fq); else E(acc, cur, wr, wc, fr, fq); S.done(cur); }
        if (!has_next) break;
#pragma unroll
        for (int a = 0; a < 2; ++a)
#pragma unroll
            for (int b = 0; b < 2; ++b)
#pragma unroll
                for (int m = 0; m < 4; ++m)
#pragma unroll
                    for (int n = 0; n < 2; ++n) acc[a][b][m][n] = (f32x4){0.f, 0.f, 0.f, 0.f};
        cur = nxt; cA = nA; cB = nB; ++ui;
        if constexpr (ALIGN_EPI) { if (wr == 1) PG8_BAR; }
    }
    PG8_WAIT_V(0);
    if constexpr (!ALIGN_EPI) { if (wr == 0) PG8_BAR; }
    PG8_BAR;
    if constexpr (Epi::AFTER_DRAIN) { E.fused(acc, cur, wr, wc, fr, fq, lds, wid, lane); S.done(cur); }
#undef PG8_SA
#undef PG8_SB
#undef PG8_STAGE
#undef PG8_LDA
#undef PG8_LDB
#undef PG8_MMA
#undef PG8_WAIT_V
#undef PG8_WAIT_L
#undef PG8_BAR
#undef PG8_SCHED
}
}
namespace att {
using bf16 = __hip_bfloat16;
typedef short bf16x8 __attribute__((ext_vector_type(8)));
typedef short s16x4 __attribute__((ext_vector_type(4)));
typedef float f32x16 __attribute__((ext_vector_type(16)));
typedef float f32x4 __attribute__((ext_vector_type(4)));
typedef unsigned u32x4 __attribute__((ext_vector_type(4)));
constexpr int D = 128, SEQ = 4096, OP = 2048;
constexpr float SCALE = 0.08838834764831845f, THR = 8.f;
constexpr int NW = 8, QBLK = 32, KVBLK = 64, QB = NW * QBLK;
constexpr int SHM_V = KVBLK * D * 2, SHM_K = KVBLK * D * 2;
constexpr int OFF_WS = 2 * SHM_V + 2 * SHM_K, OFF_BIAS = OFF_WS + NW * 64 * 4, BIAS_BYTES = SEQ * 4, LDS_BYTES = OFF_BIAS + 2 * BIAS_BYTES;

#define KSWZ(row, colB) ((row) * 256 + ((colB) ^ (((row) & 7) << 4)))
#define SBAR() __builtin_amdgcn_sched_barrier(0)
__device__ __forceinline__ int v_st(int k, int c) { const int kk = (k & ~0xC) | ((k & 4) << 1) | ((k & 8) >> 1); return ((kk >> 3) * 4 + (c >> 5)) * 512 + ((kk & 7) * 32 + (c & 31)) * 2; }
__device__ __forceinline__ int v_rd_base(int lane) { return ((lane & 3) << 3) | (((lane >> 2) & 3) << 6) | (((lane >> 4) & 1) << 5) | (((lane >> 5) & 1) << 8); }
constexpr int v_rd_off(int d0, int ks, int half) { return d0 * 512 + ks * 4096 + half * 2048; }
__device__ __forceinline__ int crow(int r, int hi) { return (r & 3) + 8 * (r >> 2) + 4 * hi; }
__device__ __forceinline__ unsigned cvtpk(float lo, float hi) { unsigned r; asm volatile("v_cvt_pk_bf16_f32 %0, %1, %2" : "=v"(r) : "v"(lo), "v"(hi)); return r; }
__device__ __forceinline__ bf16x8 load8(const bf16* p) { return *reinterpret_cast<const bf16x8*>(p); }
__device__ __forceinline__ bf16x8 ldg16(const char* sb, unsigned off) { return *reinterpret_cast<const bf16x8*>(sb + off); }
__device__ __forceinline__ void mask_tile(f32x16& p0, f32x16& p1, int dq, unsigned W) {
    const float NEG = -__builtin_inff();
#pragma unroll
    for (int r = 0; r < 16; ++r) {
        const int c = (r & 3) + 8 * (r >> 2);
        if ((unsigned)(dq - c) >= W) p0[r] = NEG;
        if ((unsigned)(dq - c - 32) >= W) p1[r] = NEG;
    }
}
__device__ __forceinline__ void partialSM(f32x16& p0, f32x16& p1, float& m_reg, float& mn, float& alpha) {
    float pmax = p0[0]; for (int r = 1; r < 16; ++r) pmax = fmaxf(pmax, p0[r]); for (int r = 0; r < 16; ++r) pmax = fmaxf(pmax, p1[r]);
    { auto rr = __builtin_amdgcn_permlane32_swap(__float_as_uint(pmax), __float_as_uint(pmax), false, false);
      pmax = fmaxf(__uint_as_float(rr[0]), __uint_as_float(rr[1])); }
    constexpr float C2 = 1.4426950408889634f * SCALE;
    if (__builtin_expect(__all((pmax - m_reg) * SCALE <= THR), 1)) { mn = m_reg; alpha = 1.f; }
    else { mn = fmaxf(m_reg, pmax); alpha = __builtin_amdgcn_exp2f((m_reg - mn) * C2); m_reg = mn; }
    const float mnL = -mn * C2;
    for (int r = 0; r < 16; ++r) p0[r] = fmaf(p0[r], C2, mnL); for (int r = 0; r < 16; ++r) p1[r] = fmaf(p1[r], C2, mnL);
    for (int r = 0; r < 16; ++r) p0[r] = __builtin_amdgcn_exp2f(p0[r]);
}
__device__ __forceinline__ void finishSM(f32x16& p0, f32x16& p1, float alpha, float& l_reg, bf16x8& pa0, bf16x8& pa1, bf16x8& pa2, bf16x8& pa3) {
    for (int r = 0; r < 16; ++r) p1[r] = __builtin_amdgcn_exp2f(p1[r]);
    float ps = 0; for (int r = 0; r < 16; ++r) ps += p0[r]; for (int r = 0; r < 16; ++r) ps += p1[r];
    { auto rr = __builtin_amdgcn_permlane32_swap(__float_as_uint(ps), __float_as_uint(ps), false, false);
      ps = __uint_as_float(rr[0]) + __uint_as_float(rr[1]); }
    l_reg = l_reg * alpha + ps;
#define PK4(P, B_, OUT) do { unsigned a0 = cvtpk(P[B_+0], P[B_+1]), a1 = cvtpk(P[B_+2], P[B_+3]);                          \
        unsigned b0 = cvtpk(P[B_+4], P[B_+5]), b1 = cvtpk(P[B_+6], P[B_+7]);                                             \
        auto r0 = __builtin_amdgcn_permlane32_swap(a0, b0, false, false); auto r1 = __builtin_amdgcn_permlane32_swap(a1, b1, false, false); \
        u32x4 w = {r0[0], r1[0], r0[1], r1[1]}; OUT = *reinterpret_cast<bf16x8*>(&w); } while (0)
    PK4(p0, 0, pa0); PK4(p0, 8, pa1); PK4(p1, 0, pa2); PK4(p1, 8, pa3);
#undef PK4
}
template <int KB>
__device__ __forceinline__ void qkt(f32x16& p0, f32x16& p1, const char* K_lds, int r32, int hi, const bf16x8* qr, const float* bp) {
#pragma unroll
    for (int g = 0; g < 4; ++g) { const f32x4 a = *(const f32x4*)(bp + 8 * g), b = *(const f32x4*)(bp + 32 + 8 * g);
        p0[4 * g] = a[0]; p0[4 * g + 1] = a[1]; p0[4 * g + 2] = a[2]; p0[4 * g + 3] = a[3];
        p1[4 * g] = b[0]; p1[4 * g + 1] = b[1]; p1[4 * g + 2] = b[2]; p1[4 * g + 3] = b[3]; }
    const char* kb[4];
#pragma unroll
    for (int dd = 0; dd < 4; ++dd) kb[dd] = K_lds + KB * SHM_K + KSWZ(r32, (dd * 16 + hi * 8) * 2);
#pragma unroll
    for (int d0 = 0; d0 < 8; ++d0) { const char* a = kb[d0 & 3] + (d0 >> 2) * 128;
        bf16x8 b0 = *reinterpret_cast<const bf16x8*>(a);
        bf16x8 b1 = *reinterpret_cast<const bf16x8*>(a + 32 * 256);
        p0 = __builtin_amdgcn_mfma_f32_32x32x16_bf16(b0, qr[d0], p0, 0, 0, 0);
        p1 = __builtin_amdgcn_mfma_f32_32x32x16_bf16(b1, qr[d0], p1, 0, 0, 0); }
}
#define TRRD(dst, off) asm volatile("ds_read_b64_tr_b16 %0, %1 offset:%2" : "=&v"(dst) : "v"(vb0), "i"(off) : "memory")
#define PV_D0(VB, d0, oo) do { s16x4 l0, l1, l2, l3, h0, h1, h2, h3; constexpr int b_ = (VB) * SHM_V + v_rd_off(d0, 0, 0);   \
        TRRD(l0, b_); TRRD(h0, b_ + 2048); TRRD(l1, b_ + 4096); TRRD(h1, b_ + 6144); TRRD(l2, b_ + 8192); TRRD(h2, b_ + 10240); TRRD(l3, b_ + 12288); TRRD(h3, b_ + 14336); \
        asm volatile("s_waitcnt lgkmcnt(0)" ::: "memory"); SBAR();                                                          \
        oo = __builtin_amdgcn_mfma_f32_32x32x16_bf16(pa0, (bf16x8){l0[0], l0[1], l0[2], l0[3], h0[0], h0[1], h0[2], h0[3]}, oo, 0, 0, 0);   \
        oo = __builtin_amdgcn_mfma_f32_32x32x16_bf16(pa1, (bf16x8){l1[0], l1[1], l1[2], l1[3], h1[0], h1[1], h1[2], h1[3]}, oo, 0, 0, 0);   \
        oo = __builtin_amdgcn_mfma_f32_32x32x16_bf16(pa2, (bf16x8){l2[0], l2[1], l2[2], l2[3], h2[0], h2[1], h2[2], h2[3]}, oo, 0, 0, 0);   \
        oo = __builtin_amdgcn_mfma_f32_32x32x16_bf16(pa3, (bf16x8){l3[0], l3[1], l3[2], l3[3], h3[0], h3[1], h3[2], h3[3]}, oo, 0, 0, 0); } while (0)
template <int VB>
__device__ __forceinline__ void pv_tile(f32x16* o, int vb0, bf16x8 pa0, bf16x8 pa1, bf16x8 pa2, bf16x8 pa3) {
    PV_D0(VB, 0, o[0]); PV_D0(VB, 1, o[1]); PV_D0(VB, 2, o[2]); PV_D0(VB, 3, o[3]);
}
template <int VB, int DA>
__device__ __forceinline__ void pv_half(f32x16* o2, int vb0, bf16x8 pa0, bf16x8 pa1, bf16x8 pa2, bf16x8 pa3) {
    PV_D0(VB, DA, o2[0]); PV_D0(VB, DA + 1, o2[1]);
}

__device__ __forceinline__ float rowsum16(const float (&sq)[16], int r32) {
    const bool b4 = r32 & 16, b3 = r32 & 8, b2 = r32 & 4, b1 = r32 & 2;
    float t[8], u[4], v[2];
#pragma unroll
    for (int j = 0; j < 8; ++j) { const float mine = b4 ? sq[8 + j] : sq[j], oth = b4 ? sq[j] : sq[8 + j]; t[j] = mine + __shfl_xor(oth, 16); }
#pragma unroll
    for (int j = 0; j < 4; ++j) { const float mine = b3 ? t[4 + j] : t[j], oth = b3 ? t[j] : t[4 + j]; u[j] = mine + __shfl_xor(oth, 8); }
#pragma unroll
    for (int j = 0; j < 2; ++j) { const float mine = b2 ? u[2 + j] : u[j], oth = b2 ? u[j] : u[2 + j]; v[j] = mine + __shfl_xor(oth, 4); }
    const float mine = b1 ? v[1] : v[0], oth = b1 ? v[0] : v[1]; float w = mine + __shfl_xor(oth, 2);
    return w + __shfl_xor(w, 1);
}
struct BlockRef { const bf16* Q; const bf16* K; const bf16* V; bf16* O; const float* NB; float* SS; int P0; };
struct Seam { bf16x8 qr[8]; bf16x8 st0, st1; };
#define VMW() asm volatile("s_waitcnt vmcnt(0)" ::: "memory")
#define VMWN(n) asm volatile("s_waitcnt vmcnt(%0)" :: "i"(n) : "memory")
#define SLOAD2(p, k0) do { const char* b_ = (const char*)(p) + (size_t)(k0) * (D * 2); S.st0 = ldg16(b_, voff); S.st1 = ldg16(b_ + 32 * D * 2, voff); } while (0)
#define SWRITE_K(bf) do { *(bf16x8*)(K_lds + (bf) * SHM_K + kws) = S.st0; *(bf16x8*)(K_lds + (bf) * SHM_K + kws + 32 * 256) = S.st1; } while (0)
#define SWRITE_V(bf) do { *(bf16x8*)(V_lds + (bf) * SHM_V + vst0) = S.st0; *(bf16x8*)(V_lds + (bf) * SHM_V + vst1) = S.st1; } while (0)
__device__ __forceinline__ void bias_to_lds(const float* NB, char* lds, int reg, const int tid) {
    const f32x4 a = *(const f32x4*)(NB + tid * 4), b = *(const f32x4*)(NB + 2048 + tid * 4);
    float* dst = (float*)(lds + OFF_BIAS + reg * BIAS_BYTES);
    *(f32x4*)(dst + tid * 4) = a; *(f32x4*)(dst + 2048 + tid * 4) = b;
}
__device__ __forceinline__ void prime(const BlockRef& cur, char* lds, Seam& S, const int tid) {
    const int wid = __builtin_amdgcn_readfirstlane(tid >> 6), lane = tid & 63, r32 = lane & 31, hi = lane >> 5;
    const int sr = tid >> 4, sc = (tid & 15) * 8, kws = KSWZ(sr, sc * 2); char* K_lds = lds + 2 * SHM_V; const unsigned voff = (unsigned)(sr * D + sc) * 2u;
#pragma unroll
    for (int d0 = 0; d0 < 8; ++d0) S.qr[d0] = load8(cur.Q + (size_t)(wid * QBLK + r32) * D + d0 * 16 + hi * 8);
    const int kb0 = ((cur.P0 + QB - 1) / KVBLK) * KVBLK;
    SLOAD2(cur.K, kb0);
    bias_to_lds(cur.NB, lds, 0, tid);
    VMW(); SWRITE_K(0); SBAR(); SLOAD2(cur.V, kb0);
    __syncthreads();
}
__device__ __forceinline__ void block(const BlockRef& cur, const BlockRef& nxt, char* lds, Seam& S, int par, const int tid) {
    const int wid = __builtin_amdgcn_readfirstlane(tid >> 6), lane = tid & 63, r32 = lane & 31, hi = lane >> 5;
    constexpr int W = SEQ;
    const int NT = (cur.P0 + QB - 1) / KVBLK + 1;
    const int qlo = cur.P0 + wid * QBLK, qm = qlo + r32 - 4 * hi;
    char* V_lds = lds; char* K_lds = lds + 2 * SHM_V;
    float* ws = (float*)(lds + OFF_WS) + wid * 64; float* li_l = ws, * al_l = ws + 32;
    const float* bl = (const float*)(lds + OFF_BIAS + par * BIAS_BYTES) + 4 * hi;
    float m_reg = -1e30f, l_reg = 0; f32x16 o[4] = {};
    const int sr = tid >> 4, sc = (tid & 15) * 8, vst0 = v_st(sr, sc), vst1 = v_st(32 + sr, sc), kws = KSWZ(sr, sc * 2); const unsigned voff = (unsigned)(sr * D + sc) * 2u;
    const int vb0 = (int)(uintptr_t)V_lds + v_rd_base(lane);
    const bf16* Kh = cur.K; const bf16* Vh = cur.V;
#define RESC(a) do { if (__any((a) < 1.f)) { if (hi == 0) al_l[r32] = (a); asm volatile("s_waitcnt lgkmcnt(0)" ::: "memory");              \
                     for (int d_ = 0; d_ < 4; ++d_) for (int r = 0; r < 16; ++r) o[d_][r] *= al_l[crow(r, hi)]; } } while (0)
#define KBASE(t) ((NT - 1 - (t)) * KVBLK)
#define MASKT(P0_, P1_, t) do { const int kb_ = KBASE(t); if (kb_ + KVBLK - 1 > qlo) mask_tile(P0_, P1_, qm - kb_, (unsigned)W); } while (0)
    f32x16 pA0, pA1, pB0, pB1; float mnA, mnB, alA, alB; bf16x8 pa0, pa1, pa2, pa3;
    VMW(); SWRITE_V(0); SBAR();
    SLOAD2(Kh, KBASE(1));
    SBAR(); qkt<0>(pA0, pA1, K_lds, r32, hi, S.qr, bl + KBASE(0));
    VMW(); SWRITE_K(1); SBAR(); SLOAD2(Vh, KBASE(1));
    MASKT(pA0, pA1, 0); partialSM(pA0, pA1, m_reg, mnA, alA);
    VMW(); SWRITE_V(1); SBAR(); if (NT > 2) SLOAD2(Kh, KBASE(2));
    __syncthreads();
#define HALF_STEP(PX0, PX1, mnX, alX, PY0, PY1, alY, t, KB, VB, SB) do {                                                      \
        SBAR(); qkt<KB>(PX0, PX1, K_lds, r32, hi, S.qr, bl + KBASE(t));                                                      \
        finishSM(PY0, PY1, alY, l_reg, pa0, pa1, pa2, pa3); SBAR();                                                           \
        if ((t) + 1 < NT) { VMW(); SWRITE_K(SB); SBAR(); SLOAD2(Vh, KBASE((t) + 1)); SBAR(); }                                \
        pv_tile<VB>(o, vb0, pa0, pa1, pa2, pa3); MASKT(PX0, PX1, (t)); partialSM(PX0, PX1, m_reg, mnX, alX);                  \
        __syncthreads();                                                                                                      \
        if ((t) + 1 < NT) { VMW(); SWRITE_V(SB); SBAR(); if ((t) + 2 < NT) SLOAD2(Kh, KBASE((t) + 2)); }                      \
        RESC(alX); __syncthreads(); } while (0)
    for (int t = 1; t + 1 < NT; t += 2) {
        HALF_STEP(pB0, pB1, mnB, alB, pA0, pA1, alA, t, 1, 0, 0);
        HALF_STEP(pA0, pA1, mnA, alA, pB0, pB1, alB, t + 1, 0, 1, 1);
    }
    SBAR(); qkt<1>(pB0, pB1, K_lds, r32, hi, S.qr, bl + KBASE(NT - 1)); SBAR();
    const int kbn = ((nxt.P0 + QB - 1) / KVBLK) * KVBLK;
    SLOAD2(nxt.K, kbn); SBAR();
#pragma unroll
    for (int d0 = 0; d0 < 8; ++d0) S.qr[d0] = load8(nxt.Q + (size_t)(wid * QBLK + r32) * D + d0 * 16 + hi * 8);
    SBAR();
    finishSM(pA0, pA1, alA, l_reg, pa0, pa1, pa2, pa3); SBAR();
    pv_tile<0>(o, vb0, pa0, pa1, pa2, pa3);
    MASKT(pB0, pB1, NT - 1); partialSM(pB0, pB1, m_reg, mnB, alB); __syncthreads(); RESC(alB);
    finishSM(pB0, pB1, alB, l_reg, pa0, pa1, pa2, pa3); SBAR(); pv_tile<1>(o, vb0, pa0, pa1, pa2, pa3);
    SBAR(); VMWN(8); SWRITE_K(0); SBAR(); SLOAD2(nxt.V, kbn); SBAR();
    if (hi == 0) li_l[r32] = l_reg; asm volatile("s_waitcnt lgkmcnt(0)" ::: "memory");
    float rli[16];
#pragma unroll
    for (int r = 0; r < 16; ++r) rli[r] = __builtin_amdgcn_rcpf(li_l[crow(r, hi)]);
    char* Owb = (char*)(cur.O + (size_t)(wid * QBLK) * OP); char* ssb = (char*)(cur.SS + (size_t)(wid * QBLK) * 8);
    const unsigned olane = (unsigned)((4 * hi) * OP + r32) * 2u, slane = (unsigned)(4 * hi * 8) * 4u;
#pragma unroll
    for (int r = 0; r < 16; ++r) { const int rc = (r & 3) + 8 * (r >> 2); float sq = 0.f;
#pragma unroll
        for (int d0 = 0; d0 < 4; ++d0) { const float v = o[d0][r] * rli[r];
            const float vn = __shfl_xor(v, 1); const unsigned w = cvtpk(v, vn); const float vr = __uint_as_float(w << 16); sq += vr * vr;
            if ((r32 & 1) == 0) *(unsigned*)(Owb + (size_t)(rc * OP + d0 * 32) * 2 + olane) = w; }
        sq += __shfl_xor(sq, 1); sq += __shfl_xor(sq, 2); sq += __shfl_xor(sq, 4); sq += __shfl_xor(sq, 8); sq += __shfl_xor(sq, 16);
        if (r32 == 0) *(float*)(ssb + (size_t)(rc * 8) * 4 + slane) = sq;
        asm volatile("" ::: "memory"); }
    bias_to_lds(nxt.NB, lds, par ^ 1, tid);
    __syncthreads();
#undef RESC
#undef KBASE
#undef MASKT
#undef HALF_STEP
}
}
namespace cg = cooperative_groups;
constexpr int NWAVES = 8;
constexpr int BATCH = 4, SEQ = 4096, DM = 2048, NH = 8, HD = 128, DA = 1024, DG = 1024, DFF = 8192, NIN = 5128, NIN2 = 5120, CHUNK = 128;
constexpr int M = BATCH * SEQ;
constexpr float EPS = 1e-6f;
constexpr size_t MiB = 1u << 20;
constexpr size_t WS_SSA = 1 * MiB, WS_SSG = 2 * MiB;
constexpr size_t WS_LF = 4 * MiB, WS_NB = 5 * MiB, WS_WSB = 6 * MiB, WS_LNST = 8 * MiB;
constexpr size_t WS_W1 = 12 * MiB, WS_WO = 32 * MiB, WS_WF1 = 40 * MiB, WS_X1B = 72 * MiB;
constexpr size_t WS_Y16 = 8 * MiB;
constexpr size_t WS_WF2 = 136 * MiB;
constexpr size_t WS_HID = 168 * MiB;
constexpr size_t WS_XN = 168 * MiB, WS_Q = 232 * MiB, WS_K = 264 * MiB, WS_V = 296 * MiB, WS_U = 328 * MiB, WS_YG = 360 * MiB, WS_ATT = 392 * MiB, WS_GM = 424 * MiB, WS_END = 456 * MiB;
constexpr int LDS_BYTES = 147456;
#define LAS __attribute__((address_space(3)))
typedef unsigned short bf16;
typedef unsigned v4u __attribute__((ext_vector_type(4)));
typedef unsigned v2u __attribute__((ext_vector_type(2)));
typedef float f32x4 __attribute__((ext_vector_type(4)));
typedef float f32x2 __attribute__((ext_vector_type(2)));
typedef short bf16x8 __attribute__((ext_vector_type(8)));
#define LDS_WAIT() asm volatile("s_waitcnt lgkmcnt(0)" ::: "memory")
__device__ __forceinline__ unsigned f2bf(float f) { unsigned u = __builtin_bit_cast(unsigned, f); return (u + 0x7fffu + ((u >> 16) & 1u)) >> 16; }
__device__ __forceinline__ unsigned pk2(float lo, float hi) { return f2bf(lo) | (f2bf(hi) << 16); }
__device__ __forceinline__ float bf_lo(unsigned w) { return __uint_as_float(w << 16); }
__device__ __forceinline__ float bf_hi(unsigned w) { return __uint_as_float(w & 0xffff0000u); }
__device__ __forceinline__ float wave_sum(float v) {
#pragma unroll
    for (int o = 1; o < 64; o <<= 1) v += __shfl_xor(v, o);
    return v;
}
__device__ __forceinline__ void p0_transpose_item(const float* W, int ldw, int K, int nblk, bf16* WT, int row_off, const float* gk, LAS float* scr, int item, int lane) {
    const int kb = item / nblk, nb = item % nblk, k0 = 64 * kb, n0 = 64 * nb;
    const int r = lane >> 4, c = lane & 15;
    f32x4 v[16];
#pragma unroll
    for (int i = 0; i < 16; ++i) v[i] = *(const f32x4*)(W + (size_t)(k0 + 4 * i + r) * ldw + n0 + 4 * c);
#pragma unroll
    for (int i = 0; i < 16; ++i) { const int k = 4 * i + r; f32x4 t = v[i]; if (gk) t = t * gk[k0 + k];
        *(LAS f32x4*)(scr + k * 64 + ((4 * c) ^ (((k >> 3) & 7) << 2))) = t; }
    LDS_WAIT(); asm volatile("" ::: "memory");
    const int nrow = lane >> 3, kc = lane & 7;
#pragma unroll
    for (int j = 0; j < 8; ++j) { const int n = 8 * j + nrow; const LAS float* sp = scr + (8 * kc) * 64 + (n ^ (kc << 2));
        v4u o; o.x = pk2(sp[0 * 64], sp[1 * 64]); o.y = pk2(sp[2 * 64], sp[3 * 64]); o.z = pk2(sp[4 * 64], sp[5 * 64]); o.w = pk2(sp[6 * 64], sp[7 * 64]);
        *(v4u*)(WT + (size_t)(row_off + n0 + n) * K + k0 + 8 * kc) = o; }
    LDS_WAIT(); asm volatile("" ::: "memory");
}

#define XB_TMO      128
#define XB_XCNT(j)  (256  + 64 * (j))
#define XB_XSUB(j)  (1280 + 64 * (j))
#define XB_XGEN(j)  (2304 + 64 * (j))
#define XB_TOP      3328
#define XB_TOPGEN   3392
#define XCD_BAR_WORDS 3456
#define XB_SPIN_CAP (1u << 18)

__device__ __forceinline__ unsigned xb_ld(unsigned* p)              { return __hip_atomic_load(p, __ATOMIC_RELAXED, __HIP_MEMORY_SCOPE_AGENT); }
__device__ __forceinline__ unsigned xb_add(unsigned* p, unsigned v) { return __hip_atomic_fetch_add(p, v, __ATOMIC_RELAXED, __HIP_MEMORY_SCOPE_AGENT); }
__device__ __forceinline__ unsigned xb_xcc_id() { return (unsigned)__builtin_amdgcn_s_getreg((3 << 11) | 20) & 0xFu; }
#define XB_SPIN(cond, bar) do { unsigned _sp = 0; while (cond) { __builtin_amdgcn_s_sleep(1); \
    if ((++_sp & 255u) == 0u) { if (xb_ld(&(bar)[XB_TMO])) break; if (_sp > XB_SPIN_CAP) { atomicAdd(&(bar)[XB_TMO], 1u); break; } } } } while (0)

struct XcdBarrier {
    unsigned* bar; unsigned x;
    volatile LAS unsigned* st;
};

__device__ __forceinline__ XcdBarrier xcd_barrier_post(unsigned* bar, volatile LAS unsigned* st, const int tid) {
    XcdBarrier b; b.bar = bar; b.x = xb_xcc_id(); b.st = st;
    if (tid == 0) (void)xb_add(&bar[XB_XCNT(b.x)], 1u);
    return b;
}
__device__ __forceinline__ void xcd_barrier_complete(unsigned* bar, unsigned x, unsigned& nloc, unsigned& nx) {
    const unsigned G = gridDim.x * gridDim.y * gridDim.z;
    unsigned sum, cnt, mine, sp = 0u;
    for (;;) {
        sum = 0u; cnt = 0u; mine = 0u;
#pragma unroll
        for (unsigned j = 0; j < 16; ++j) { const unsigned c = xb_ld(&bar[XB_XCNT(j)]); sum += c; cnt += (c > 0u) ? 1u : 0u; mine = (j == x) ? c : mine; }
        if (sum == G) break;
        __builtin_amdgcn_s_sleep(1);
        if ((++sp & 255u) == 0u) { if (xb_ld(&bar[XB_TMO])) break; if (sp > XB_SPIN_CAP) { atomicAdd(&bar[XB_TMO], 1u); break; } }
    }
    nloc = mine > 0u ? mine : 1u; nx = cnt > 0u ? cnt : 1u;
}

__device__ __forceinline__ void xcd_barrier(const XcdBarrier& b, const int tid) {
    asm volatile("s_waitcnt vmcnt(0)" ::: "memory");
    __syncthreads();
    if (tid == 0) {
        unsigned* bar = b.bar;
        __builtin_amdgcn_s_waitcnt(0);
        unsigned nloc = b.st[0], nx = b.st[1];
        if (nloc == 0u) { xcd_barrier_complete(bar, b.x, nloc, nx); b.st[0] = nloc; b.st[1] = nx; }
        const unsigned old = xb_add(&bar[XB_XSUB(b.x)], 1u);
        const unsigned gen = old / nloc;
        if (old + 1u == (gen + 1u) * nloc) {
            __builtin_amdgcn_fence(__ATOMIC_RELEASE, "agent");
            asm volatile("s_waitcnt vmcnt(0)" ::: "memory");
            const unsigned og = xb_add(&bar[XB_TOP], 1u);
            const unsigned tg = og / nx;
            if (og + 1u == (tg + 1u) * nx) xb_add(&bar[XB_TOPGEN], 1u);
            else XB_SPIN(xb_ld(&bar[XB_TOPGEN]) == tg, bar);
            __builtin_amdgcn_fence(__ATOMIC_ACQUIRE, "agent");
            xb_add(&bar[XB_XGEN(b.x)], 1u);
            asm volatile("s_waitcnt vmcnt(0)" ::: "memory");
        } else {
            XB_SPIN(xb_ld(&bar[XB_XGEN(b.x)]) == gen, bar);
            __builtin_amdgcn_fence(__ATOMIC_ACQUIRE, "agent");
            asm volatile("s_waitcnt vmcnt(0)" ::: "memory");
        }
    }
    __syncthreads();
}

struct Args { const float* in[15]; float* out; unsigned char* ws; };
__device__ __forceinline__ int lane_id_fresh() { int z = 0; asm volatile("" : "+v"(z)); return __builtin_amdgcn_mbcnt_hi(~0u, __builtin_amdgcn_mbcnt_lo(~0u, z)); }
__device__ __forceinline__ att::BlockRef mk_block_ref(int LL, int ps, const bf16* Qb, const bf16* Kb, const bf16* Vb, bf16* MG, const float* NB, float* SSA) {
    constexpr int NQB = SEQ / 256, NX = NQB / 2;
    const int bh = LL / NX, xx = LL % NX, qb = ps ? NQB - 1 - xx : xx, b = bh / NH, h = bh % NH; att::BlockRef r;
    r.Q = (const att::bf16*)Qb + ((size_t)bh * SEQ + (size_t)qb * 256) * HD; r.K = (const att::bf16*)Kb + (size_t)bh * SEQ * HD; r.V = (const att::bf16*)Vb + (size_t)bh * SEQ * HD;
    const size_t row0 = (size_t)b * SEQ + (size_t)qb * 256;
    r.O = (att::bf16*)MG + row0 * DM + h * HD; r.NB = NB + (size_t)bh * SEQ; r.SS = SSA + row0 * 8 + h; r.P0 = qb * 256; return r;
}

__global__ void __launch_bounds__(NWAVES * 64, 2) mk_fwd(Args args) {
    extern __shared__ __attribute__((aligned(16))) unsigned char lds[];
    cg::grid_group grid = cg::this_grid();
    LAS unsigned char* ldsl = (LAS unsigned char*)lds;
    const int wave = __builtin_amdgcn_readfirstlane((int)threadIdx.x >> 6);
#define FRESH_TID const int lane = lane_id_fresh(), tid = wave * 64 + lane; (void)tid
    const int G = gridDim.x; const int bx = blockIdx.x; const int vcu = (G % 8 == 0) ? (bx % 8) * (G / 8) + bx / 8 : bx;
    volatile LAS unsigned* bst = (volatile LAS unsigned*)(ldsl + 131072 + 64);
    if (threadIdx.x == 0) { bst[0] = 0u; bst[1] = 0u; }
    typedef const __attribute__((address_space(4))) Args* ArgP;
#define SEAM() do { FRESH_TID; xcd_barrier(xbar, tid); } while (0)
    ArgP ap = (ArgP)__builtin_amdgcn_kernarg_segment_ptr();
#define PHASE_ARGS FRESH_TID; ArgP A_ = ap; asm volatile("" : "+s"(A_)); unsigned char* ws = A_->ws; (void)ws
#define INP(i) (A_->in[i])
    const int gw = vcu * NWAVES + wave, NGW = G * NWAVES;
    if (ap->ws == nullptr) { grid.sync(); return; }
    XcdBarrier xbar; { FRESH_TID; xbar = xcd_barrier_post((unsigned*)ap->ws, bst, tid); }

#ifndef REPS
#define REPS 0x1111111111ull
#endif
#define REP(k) for (int rep_ = 0; rep_ < (int)((REPS >> (4 * (k))) & 15); ++rep_)
    REP(0) {
        PHASE_ARGS; const float* x = INP(0); const float* g_mix = INP(1); const float* w_in = INP(2); const float* b_f = INP(3); const float* w_s = INP(6); const float* g_att = INP(8); const float* g_gm = INP(9); const float* w_out = INP(10); const float* g_ffn = INP(11); const float* w_ff1 = INP(12); const float* w_ff2 = INP(13);
        bf16* W1t = (bf16*)(ws + WS_W1); bf16* WOt = (bf16*)(ws + WS_WO); bf16* WF1t = (bf16*)(ws + WS_WF1); bf16* WF2t = (bf16*)(ws + WS_WF2); bf16* WSB = (bf16*)(ws + WS_WSB); bf16* XN = (bf16*)(ws + WS_XN); float* LF = (float*)(ws + WS_LF);
        LAS float* scr = (LAS float*)(ldsl + wave * 16384);
        constexpr int I_A = 32 * 48, I_B = 32 * 32, I_O = 32 * 32, I_1 = 32 * 128, I_2 = 128 * 32, NITEMS = I_A + I_B + I_O + I_1 + I_2;
        for (int it = gw; it < NITEMS; it += NGW) {
            int r = it;
            if (r < I_A) { p0_transpose_item(w_in, NIN, DM, 48, W1t, 0, nullptr, scr, r, lane); continue; } r -= I_A;
            if (r < I_B) { p0_transpose_item(w_in + 3080, NIN, DM, 32, W1t, 3072, nullptr, scr, r, lane); continue; } r -= I_B;
            if (r < I_O) { p0_transpose_item(w_out, DM, DM, 32, WOt, 0, (r / 32) * 64 < DA ? g_att : g_gm - DA, scr, r, lane); continue; } r -= I_O;
            if (r < I_1) { p0_transpose_item(w_ff1, DFF, DM, 128, WF1t, 0, g_ffn, scr, r, lane); continue; } r -= I_1;
            p0_transpose_item(w_ff2, DM, DFF, 32, WF2t, 0, nullptr, scr, r, lane);
        }
        for (int i = bx * 512 + tid; i < 8 * 128 * 128 / 8; i += G * 512) { const int e0 = i * 8, t = (e0 >> 7) & 127, s0 = e0 & 127;
            const f32x4 a = *(const f32x4*)(w_s + e0), b = *(const f32x4*)(w_s + e0 + 4); float v[8] = {a[0], a[1], a[2], a[3], b[0], b[1], b[2], b[3]};
#pragma unroll
            for (int e = 0; e < 8; ++e) if (s0 + e > t) v[e] = 0.f;
            v4u o; o.x = pk2(v[0], v[1]); o.y = pk2(v[2], v[3]); o.z = pk2(v[4], v[5]); o.w = pk2(v[6], v[7]); *(v4u*)(WSB + e0) = o; }
        __syncthreads();
        LAS f32x4* WF = (LAS f32x4*)ldsl;
        for (int k = tid; k < DM; k += 512) { const f32x4 a = *(const f32x4*)(w_in + (size_t)k * NIN + 3072), b = *(const f32x4*)(w_in + (size_t)k * NIN + 3076);
            const int q4 = k >> 2, i = k & 3, j = q4 >> 6, l = q4 & 63; WF[((j * 4 + i) * 2 + 0) * 64 + l] = a; WF[((j * 4 + i) * 2 + 1) * 64 + l] = b; }
        __syncthreads();
        f32x4 gv[8];
#pragma unroll
        for (int j = 0; j < 8; ++j) gv[j] = *((const f32x4*)g_mix + lane + 64 * j);
        f32x4 nx[8];
#pragma unroll
        for (int j = 0; j < 8; ++j) nx[j] = *((const f32x4*)(x + (size_t)gw * DM) + lane + 64 * j);
        for (int m = gw; m < M; m += NGW) {
            asm volatile("" ::: "memory");
            f32x4 v[8]; float s = 0.f;
#pragma unroll
            for (int j = 0; j < 8; ++j) { v[j] = nx[j]; s += (v[j][0] * v[j][0] + v[j][1] * v[j][1]) + (v[j][2] * v[j][2] + v[j][3] * v[j][3]); }
            if (m + NGW < M) {
#pragma unroll
                for (int j = 0; j < 8; ++j) nx[j] = *((const f32x4*)(x + (size_t)(m + NGW) * DM) + lane + 64 * j); }
            const float rs = 1.0f / sqrtf(wave_sum(s) * (1.f / DM) + EPS);
            unsigned long long* o8 = (unsigned long long*)(XN + (size_t)m * DM) + lane;
            float zf[8] = {0.f, 0.f, 0.f, 0.f, 0.f, 0.f, 0.f, 0.f};
#pragma unroll
            for (int j = 0; j < 8; ++j) { v[j] = v[j] * rs * gv[j];
                o8[64 * j] = (unsigned long long)pk2(v[j][0], v[j][1]) | ((unsigned long long)pk2(v[j][2], v[j][3]) << 32);
#pragma unroll
                for (int i = 0; i < 4; ++i) { const f32x4 wa = WF[((j * 4 + i) * 2 + 0) * 64 + lane], wb = WF[((j * 4 + i) * 2 + 1) * 64 + lane]; const float hv = v[j][i];
                    zf[0] += hv * wa[0]; zf[1] += hv * wa[1]; zf[2] += hv * wa[2]; zf[3] += hv * wa[3]; zf[4] += hv * wb[0]; zf[5] += hv * wb[1]; zf[6] += hv * wb[2]; zf[7] += hv * wb[3]; } }
            float mine = 0.f;
#pragma unroll
            for (int h = 0; h < 8; ++h) { const float t = wave_sum(zf[h]); if (lane == h) mine = t; }
            if (lane < 8) { const float a = mine + b_f[lane]; const float lf = fminf(a, 0.f) - log1pf(expf(-fabsf(a)));
                const int b = m / SEQ, sidx = m % SEQ; LF[(size_t)(b * NH + lane) * SEQ + sidx] = lf; }
        }
    }
    SEAM();

    REP(1) if (bx < BATCH * NH && wave == 0) {
        PHASE_ARGS; float* LF = (float*)(ws + WS_LF); float* NB = (float*)(ws + WS_NB);
        const float* src = LF + (size_t)bx * SEQ + lane * 64; float* dst = NB + (size_t)bx * SEQ + lane * 64;
        float tot = 0.f;
#pragma unroll
        for (int i = 0; i < 16; ++i) { const f32x4 a = *(const f32x4*)(src + 4 * i); tot += (a[0] + a[1]) + (a[2] + a[3]); }
        float incl = tot;
#pragma unroll
        for (int o = 1; o < 64; o <<= 1) { const float t = __shfl_up(incl, o); if (lane >= o) incl += t; }
        float run = incl - tot;
        const float c = -11.313708498984761f;
#pragma unroll
        for (int i = 0; i < 16; ++i) { const f32x4 a = *(const f32x4*)(src + 4 * i); f32x4 r; run += a[0]; r[0] = run * c; run += a[1]; r[1] = run * c; run += a[2]; r[2] = run * c; run += a[3]; r[3] = run * c; *(f32x4*)(dst + 4 * i) = r; }
    }
    REP(2) {
        PHASE_ARGS; bf16* XN = (bf16*)(ws + WS_XN); bf16* W1t = (bf16*)(ws + WS_W1); bf16* Qb = (bf16*)(ws + WS_Q); bf16* Kb = (bf16*)(ws + WS_K); bf16* Vb = (bf16*)(ws + WS_V); bf16* Ub = (bf16*)(ws + WS_U); bf16* Yb = (bf16*)(ws + WS_YG); float* LNST = (float*)(ws + WS_LNST);
        pg8::Gemm g{XN, W1t, M, NIN2, DM}; pg8::StaticOrder S; S.init(M, NIN2, G, bx);
        pg8::EpiIn E{Qb, Kb, Vb, Ub, Yb, LNST};
        pg8::gemm_phase<pg8::EpiIn, pg8::StaticOrder, true, true>(ldsl, g, S, E, tid);
    }
    SEAM();

    {
        PHASE_ARGS; const float* ln_g = INP(4); const float* ln_b = INP(5); const float* b_s = INP(7);
        bf16* Qb = (bf16*)(ws + WS_Q); bf16* Kb = (bf16*)(ws + WS_K); bf16* Vb = (bf16*)(ws + WS_V); bf16* Ub = (bf16*)(ws + WS_U); bf16* Yb = (bf16*)(ws + WS_YG); bf16* MG = (bf16*)(ws + WS_XN);
        float* NB = (float*)(ws + WS_NB); float* LNST = (float*)(ws + WS_LNST); bf16* WSB = (bf16*)(ws + WS_WSB); float* SSA = (float*)(ws + WS_SSA); float* SSG = (float*)(ws + WS_SSG);
        char* shm = (char*)lds;
        constexpr int NQB = SEQ / 256, NX = NQB / 2, TOTAL = BATCH * NH * NX;
#ifndef ATT_DUP
#define ATT_DUP 1
#endif
#ifndef SYNC_DUP
#define SYNC_DUP 0
#endif
        for (int sd_ = 0; sd_ < SYNC_DUP; ++sd_) SEAM();
        REP(4) {
            const int r32 = lane & 31, hi = lane >> 5, rg = wave & 3, dh = wave >> 2;
            float* st = (float*)(shm + att::OFF_WS);
            char* V_lds = shm;
            const int vb0 = (int)(uintptr_t)V_lds + att::v_rd_base(lane);
            const int sr = tid >> 4, sc = (tid & 15) * 8;
#ifndef GM_DUP
#define GM_DUP 1
#endif
            constexpr int NUNITS = (M / CHUNK) * NH * GM_DUP;
            int hprev = -1;
            bf16x8 pw[8];
            v4u yv[4]; f32x4 sv[2]; unsigned uv[16];
            const unsigned ulane = (unsigned)((4 * hi) * DG + 2 * r32) * 2u, olane = (unsigned)((4 * hi) * DM + 2 * r32) * 2u;
#define GM_LOAD_Y(un) do { const int ch_ = ((un) >> 3) % (M / CHUNK), h_ = (un) & 7; const size_t m_ = (size_t)ch_ * CHUNK;                     \
                _Pragma("unroll") for (int q = 0; q < 4; ++q) yv[q] = *(const v4u*)(Yb + (m_ + q * 32 + sr) * DG + h_ * HD + sc);          \
                const f32x4* p_ = (const f32x4*)(LNST + (m_ + (tid >> 2)) * 32) + 2 * (tid & 3); sv[0] = p_[0]; sv[1] = p_[1]; } while (0)
#define GM_LOAD_U(un) do { const int ch_ = ((un) >> 3) % (M / CHUNK), h_ = (un) & 7; const char* ub_ = (const char*)(Ub + ((size_t)ch_ * CHUNK + rg * 32) * DG + h_ * HD + dh * 64);   \
                _Pragma("unroll") for (int r = 0; r < 16; ++r) { const int rc_ = (r & 3) + 8 * (r >> 2); uv[r] = *(const unsigned*)(ub_ + (size_t)(rc_ * DG) * 2 + ulane); } } while (0)
            int unit = vcu;
            if (unit < NUNITS) { GM_LOAD_Y(unit); GM_LOAD_U(unit); }
            for (; unit < NUNITS; unit += G) {
                const int ch = (unit >> 3) % (M / CHUNK), h = unit & 7; const size_t m0 = (size_t)ch * CHUNK;
                if (h != hprev) { hprev = h;
                    const bf16* wrow = WSB + ((size_t)h * CHUNK + rg * 32 + r32) * CHUNK + 8 * hi;
#pragma unroll
                    for (int i = 0; i < 8; ++i) pw[i] = *(const bf16x8*)(wrow + 16 * i); }
                const f32x4 g0 = *(const f32x4*)(ln_g + h * HD + sc), g1 = *(const f32x4*)(ln_g + h * HD + sc + 4), c0 = *(const f32x4*)(ln_b + h * HD + sc), c1 = *(const f32x4*)(ln_b + h * HD + sc + 4);
                { float s1 = (sv[0][0] + sv[0][2]) + (sv[1][0] + sv[1][2]), s2 = (sv[0][1] + sv[0][3]) + (sv[1][1] + sv[1][3]);
                  s1 += __shfl_xor(s1, 1); s1 += __shfl_xor(s1, 2); s2 += __shfl_xor(s2, 1); s2 += __shfl_xor(s2, 2);
                  if ((tid & 3) == 0) { const float mu = s1 * (1.f / DG), var = fmaxf(s2 * (1.f / DG) - mu * mu, 0.f); st[2 * (tid >> 2)] = mu; st[2 * (tid >> 2) + 1] = 1.0f / sqrtf(var + EPS); } }
                __syncthreads();
                { const int cpos = ((sc >> 6) * 2) * 32 + ((sc & 63) >> 1);
#pragma unroll
                  for (int q = 0; q < 4; ++q) { const int key = q * 32 + sr;
                    const v4u w = yv[q]; const float mu = st[2 * key], rsd = st[2 * key + 1];
                    const float e0 = (bf_lo(w.x) - mu) * rsd * g0[0] + c0[0], e1 = (bf_hi(w.x) - mu) * rsd * g0[1] + c0[1], e2 = (bf_lo(w.y) - mu) * rsd * g0[2] + c0[2], e3 = (bf_hi(w.y) - mu) * rsd * g0[3] + c0[3];
                    const float e4 = (bf_lo(w.z) - mu) * rsd * g1[0] + c1[0], e5 = (bf_hi(w.z) - mu) * rsd * g1[1] + c1[1], e6 = (bf_lo(w.w) - mu) * rsd * g1[2] + c1[2], e7 = (bf_hi(w.w) - mu) * rsd * g1[3] + c1[3];
                    char* vt = V_lds + (q >> 1) * att::SHM_V; const int krow = (q & 1) * 32 + sr;
                    *(v2u*)(vt + att::v_st(krow, cpos)) = (v2u){pk2(e0, e2), pk2(e4, e6)};
                    *(v2u*)(vt + att::v_st(krow, cpos + 32)) = (v2u){pk2(e1, e3), pk2(e5, e7)}; } }
                att::f32x16 o2[2];
                { const char* bb = (const char*)(b_s + h * CHUNK + rg * 32);
#pragma unroll
                  for (int g = 0; g < 4; ++g) { const f32x4 bv = *(const f32x4*)(bb + (size_t)(8 * g) * 4 + (unsigned)(4 * hi) * 4u);
#pragma unroll
                      for (int i = 0; i < 4; ++i) { o2[0][4 * g + i] = bv[i]; o2[1][4 * g + i] = bv[i]; } } }
                __syncthreads();
                const int nu = unit + G;
                if (nu < NUNITS) GM_LOAD_Y(nu);
                if (dh == 0) att::pv_half<0, 0>(o2, vb0, pw[0], pw[1], pw[2], pw[3]); else att::pv_half<0, 2>(o2, vb0, pw[0], pw[1], pw[2], pw[3]);
                if (rg >= 2) { if (dh == 0) att::pv_half<1, 0>(o2, vb0, pw[4], pw[5], pw[6], pw[7]); else att::pv_half<1, 2>(o2, vb0, pw[4], pw[5], pw[6], pw[7]); }
                char* ob = (char*)(MG + (m0 + rg * 32) * DM + DA + h * HD + dh * 64); char* sb = (char*)(SSG + (m0 + rg * 32) * 16 + h * 2 + dh);
                float sqv[16];
#pragma unroll
                for (int r = 0; r < 16; ++r) { const int rc = (r & 3) + 8 * (r >> 2);
                    const float v0 = bf_lo(uv[r]) * o2[0][r], v1 = bf_hi(uv[r]) * o2[1][r];
                    const unsigned w = att::cvtpk(v0, v1); const float r0 = bf_lo(w), r1 = bf_hi(w); sqv[r] = r0 * r0 + r1 * r1;
                    *(unsigned*)(ob + (size_t)(rc * DM) * 2 + olane) = w; }
                if (nu < NUNITS) GM_LOAD_U(nu);
                { const float tot = att::rowsum16(sqv, r32); const int rr = r32 >> 1;
                  if ((r32 & 1) == 0) *(float*)(sb + (size_t)(((rr & 3) + 8 * (rr >> 2)) * 16) * 4 + (unsigned)(4 * hi * 16) * 4u) = tot; }
                __syncthreads();
            }
#undef GM_LOAD_Y
#undef GM_LOAD_U
        }
        __syncthreads();
        if (vcu < TOTAL) {
            int L = vcu, pass = 0, par = 0;
#define mkref(LL, ps) mk_block_ref((LL) % TOTAL, (ps), Qb, Kb, Vb, MG, NB, SSA)
            att::BlockRef cur = mkref(L, 0);
            att::Seam S;
            att::prime(cur, shm, S, tid);
            for (;;) {
                const bool more_pass = pass == 0, more_item = L + G < TOTAL * ATT_DUP, last = !more_pass && !more_item;
                int passn = pass + 1, Ln = L;
                if (!more_pass) { passn = 0; Ln = more_item ? L + G : L; }
                const att::BlockRef nxt = last ? cur : mkref(Ln, passn);
                att::block(cur, nxt, shm, S, par, tid);
                if (last) break;
                cur = nxt; pass = passn; L = Ln; par ^= 1;
            }
        }
    }
    SEAM();

    REP(6) {
        PHASE_ARGS; const float* x = INP(0); bf16* XN = (bf16*)(ws + WS_XN); bf16* WOt = (bf16*)(ws + WS_WO); bf16* X1B = (bf16*)(ws + WS_X1B); const float* SSA = (const float*)(ws + WS_SSA); const float* SSG = (const float*)(ws + WS_SSG);
        pg8::Gemm g{XN, WOt, M, DM, DM}; pg8::StaticOrder S; S.init(M, DM, G, bx);
        LAS f32x2* tab = (LAS f32x2*)(ldsl + 131072 + 256);
        { pg8::Unit uu; int nun = 0; while (nun < 7 && S.next(nun, uu)) ++nun;
          for (int idx = tid; idx < nun * 256; idx += 512) { S.next(idx >> 8, uu); const size_t row = (size_t)uu.pm * 256 + (idx & 255);
              const f32x4 a0 = *(const f32x4*)(SSA + row * 8), a1 = *(const f32x4*)(SSA + row * 8 + 4);
              const f32x4 q0 = *(const f32x4*)(SSG + row * 16), q1 = *(const f32x4*)(SSG + row * 16 + 4), q2 = *(const f32x4*)(SSG + row * 16 + 8), q3 = *(const f32x4*)(SSG + row * 16 + 12);
              const float sa = ((a0[0] + a0[1]) + (a0[2] + a0[3])) + ((a1[0] + a1[1]) + (a1[2] + a1[3]));
              const float sg = (((q0[0] + q0[1]) + (q0[2] + q0[3])) + ((q1[0] + q1[1]) + (q1[2] + q1[3]))) + (((q2[0] + q2[1]) + (q2[2] + q2[3])) + ((q3[0] + q3[1]) + (q3[2] + q3[3])));
              const float rsa = 1.0f / sqrtf(sa * (1.f / 1024.f) + EPS), rsg = 1.0f / sqrtf(sg * (1.f / 1024.f) + EPS);
              tab[idx] = (f32x2){rsa / rsg, rsg}; }
          __syncthreads(); }
        pg8::EpiRes E{x, X1B, tab};
        pg8::gemm_phase<pg8::EpiRes, pg8::StaticOrder, true, true>(ldsl, g, S, E, tid);
    }
    SEAM();

    REP(7) {
        PHASE_ARGS; bf16* X1B = (bf16*)(ws + WS_X1B); bf16* WF1t = (bf16*)(ws + WS_WF1); bf16* HID = (bf16*)(ws + WS_HID);
        pg8::Gemm g{X1B, WF1t, M, DFF, DM}; pg8::StaticOrder S; S.init(M, DFF, G, bx);
        pg8::EpiRelu2 E{HID, DFF};
        pg8::gemm_phase<pg8::EpiRelu2, pg8::StaticOrder, true, true>(ldsl, g, S, E, tid);
    }
    SEAM();

    REP(8) {
        PHASE_ARGS; bf16* HID = (bf16*)(ws + WS_HID); bf16* WF2t = (bf16*)(ws + WS_WF2); bf16* Y16 = (bf16*)(ws + WS_Y16);
        pg8::Gemm g{HID, WF2t, M, DM, DFF}; pg8::StaticOrder S; S.init(M, DM, G, bx);
        pg8::EpiY16 E{Y16};
        pg8::gemm_phase<pg8::EpiY16, pg8::StaticOrder, true, true>(ldsl, g, S, E, tid);
    }
    SEAM();

    REP(9) {
        PHASE_ARGS; const float* g_fin = INP(14); const bf16* X1B = (const bf16*)(ws + WS_X1B); const bf16* Y16 = (const bf16*)(ws + WS_Y16); float* OUT = A_->out;
        for (int m = gw; m < M; m += NGW) {
            const v2u* xr = (const v2u*)(X1B + (size_t)m * DM) + lane; const v2u* yr = (const v2u*)(Y16 + (size_t)m * DM) + lane;
            f32x4 v[8], y[8]; float s = 0.f;
#pragma unroll
            for (int j = 0; j < 8; ++j) { const v2u w = xr[64 * j], wy = yr[64 * j]; y[j] = (f32x4){bf_lo(wy.x), bf_hi(wy.x), bf_lo(wy.y), bf_hi(wy.y)}; v[j] = (f32x4){bf_lo(w.x), bf_hi(w.x), bf_lo(w.y), bf_hi(w.y)}; s += (v[j][0] * v[j][0] + v[j][1] * v[j][1]) + (v[j][2] * v[j][2] + v[j][3] * v[j][3]); }
            const float r1 = 1.0f / (wave_sum(s) * (1.f / DM) + EPS);
            float s2 = 0.f;
#pragma unroll
            for (int j = 0; j < 8; ++j) { v[j] = v[j] + y[j] * r1; s2 += (v[j][0] * v[j][0] + v[j][1] * v[j][1]) + (v[j][2] * v[j][2] + v[j][3] * v[j][3]); }
            const float r2 = 1.0f / sqrtf(wave_sum(s2) * (1.f / DM) + EPS);
            f32x4* orow = (f32x4*)(OUT + (size_t)m * DM) + lane;
#pragma unroll
            for (int j = 0; j < 8; ++j) orow[64 * j] = v[j] * r2 * *((const f32x4*)g_fin + lane + 64 * j);
        }
    }
}

extern "C" void kernel_launch(void* const* d_in, const int* in_sizes, int n_in, void* d_out, int out_size, void* d_ws, size_t ws_size, hipStream_t stream) {
    static int grid = 0;
    if (grid == 0) {
        if (n_in != 15 || in_sizes[0] != M * DM || out_size != M * DM || ws_size < WS_END) { fprintf(stderr, "kernel_launch: shape/workspace mismatch (n_in %d, in0 %d, out %d, ws %zu < %zu)\n", n_in, n_in > 0 ? in_sizes[0] : -1, out_size, ws_size, (size_t)WS_END); grid = -1; return; }
        int dev = 0, cus = 0, per_cu = 0;
        hipGetDevice(&dev); hipDeviceGetAttribute(&cus, hipDeviceAttributeMultiprocessorCount, dev);
        if (hipFuncSetAttribute((const void*)mk_fwd, hipFuncAttributeMaxDynamicSharedMemorySize, LDS_BYTES) != hipSuccess) { fprintf(stderr, "kernel_launch: hipFuncSetAttribute failed\n"); grid = -1; return; }
        if (hipOccupancyMaxActiveBlocksPerMultiprocessor(&per_cu, (const void*)mk_fwd, NWAVES * 64, LDS_BYTES) != hipSuccess || per_cu < 1) { fprintf(stderr, "kernel_launch: occupancy query says %d\n", per_cu); per_cu = 1; }
        (void)hipGetLastError();
        grid = cus * per_cu;
    }
    if (grid < 0) return;
    if (hipMemsetAsync(d_ws, 0, 16384, stream) != hipSuccess) { fprintf(stderr, "kernel_launch: hipMemsetAsync of the barrier words failed\n"); return; }
    Args a{};
    for (int i = 0; i < 15; ++i) a.in[i] = (const float*)d_in[i];
    a.out = (float*)d_out; a.ws = (unsigned char*)d_ws;
    void* kargs[] = {&a};
    hipError_t e = hipLaunchCooperativeKernel((const void*)mk_fwd, dim3(grid), dim3(NWAVES * 64), kargs, LDS_BYTES, stream);
    if (e != hipSuccess) fprintf(stderr, "cooperative launch failed: %s (grid %d)\n", hipGetErrorString(e), grid);
}
```

```cpp
#include <hip/hip_runtime.h>
#include <hip/hip_cooperative_groups.h>
#include <hip/hip_bf16.h>
#include <cstdio>
#include <cstdint>
#include <cmath>
namespace pg8 {
#define PG8_LAS __attribute__((address_space(3)))
typedef unsigned short bf16_t;
typedef short bf16x8 __attribute__((ext_vector_type(8)));
typedef float f32x4 __attribute__((ext_vector_type(4)));
typedef unsigned u32x4 __attribute__((ext_vector_type(4)));
constexpr int BM = 256, BK = 64, HALF = 128, HTB = HALF * BK * 2  , STAGE_BYTES = 8 * HTB, NXCD = 8, WGM = 4;

__host__ __device__ __forceinline__ int lds_byte(int r, int c) { const int st = (r >> 4) * 2 + (c >> 5), rr = r & 15, cc = c & 31, ob = rr * 64 + cc * 2; return st * 1024 + (ob ^ (((ob >> 9) & 1) << 5)); }
__host__ __device__ __forceinline__ void stage_rc(int b, int& R, int& C) { const int st = b / 1024, sb = b % 1024, swz = sb ^ (((sb >> 9) & 1) << 5); R = (st >> 1) * 16 + swz / 64; C = (st & 1) * 32 + (swz % 64) / 2; }
__host__ __device__ __forceinline__ int perm32(int rho) { const int n = rho >> 4, i = rho & 15; return 8 * (i >> 2) + 4 * n + (i & 3); }

struct Unit { int pm, pn; };
struct Gemm { const bf16_t* A; const bf16_t* Bt; int M, N, K; };

struct StaticOrder {
    int nM, nN, nwg, G, c;
    __host__ __device__ void init(int M, int N, int G_, int c_) { nM = M / BM; nN = N / BM; nwg = nM * nN; G = G_; c = c_; }
    __host__ __device__ bool next(int i, Unit& u) const {
        const long L = (long)i * G + c; if (L >= nwg) return false;
        int wgid = (int)L; { const int q = nwg / NXCD, r = nwg % NXCD, xcd = wgid % NXCD, off = wgid / NXCD; wgid = (xcd < r ? xcd * (q + 1) : r * (q + 1) + (xcd - r) * q) + off; }
        const int nig = WGM * nN, gid = wgid / nig, fm = gid * WGM, gsz = (nM - fm) < WGM ? (nM - fm) : WGM;
        u.pm = fm + ((wgid % nig) % gsz); u.pn = (wgid % nig) / gsz; return true;
    }
    __device__ __forceinline__ void a_ready(const Unit&) const {}
    __device__ __forceinline__ void done(const Unit&) const {}
};

__device__ __forceinline__ unsigned cvt_pk_bf16(float lo, float hi) { unsigned r; asm volatile("v_cvt_pk_bf16_f32 %0, %1, %2" : "=v"(r) : "v"(lo), "v"(hi)); return r; }
typedef float f32x2 __attribute__((ext_vector_type(2)));
typedef unsigned u32x2 __attribute__((ext_vector_type(2)));
__device__ __forceinline__ float gelu_tanh(float v) {
    const float t = v * (1.0f + 0.044715f * v * v);
    const float e = __builtin_amdgcn_exp2f(-2.302208198f * t);
    return v * __builtin_amdgcn_rcpf(1.0f + e);
}
constexpr int SEQ_ = 4096, NH_ = 8;
struct EpiIn {
    static constexpr bool PERM = true, AFTER_DRAIN = false, MIDHOOK = false;
    bf16_t* Q; bf16_t* Kk; bf16_t* V; bf16_t* U; bf16_t* Y; float* lnst;
    __device__ __forceinline__ void operator()(const f32x4 (&acc)[2][2][4][2], const Unit& u, int wr, int wc, int fr, int fq) const {
        const int grp = u.pn >> 2, sub = u.pn & 3;
        const int row0 = u.pm * BM + wr * 64 + fr;
        if (grp < 3) {
            bf16_t* base = Q + (size_t)grp * (size_t)(16u << 20);
#pragma unroll
            for (int ai = 0; ai < 2; ++ai)
#pragma unroll
                for (int m = 0; m < 4; ++m) { const int row = row0 + ai * HALF + m * 16; const int b = row / SEQ_, s = row % SEQ_;
#pragma unroll
                    for (int bj = 0; bj < 2; ++bj) { const int head = sub * 2 + bj;
                        bf16_t* p = base + ((size_t)(b * NH_ + head) * SEQ_ + s) * 128 + wc * 32 + 8 * fq;
                        const f32x4 v0 = acc[ai][bj][m][0], v1 = acc[ai][bj][m][1];
                        u32x4 w; w.x = cvt_pk_bf16(v0[0], v0[1]); w.y = cvt_pk_bf16(v0[2], v0[3]); w.z = cvt_pk_bf16(v1[0], v1[1]); w.w = cvt_pk_bf16(v1[2], v1[3]);
                        *(u32x4*)p = w; } }
        } else {
            bf16_t* base = Q + (size_t)grp * (size_t)(16u << 20);
#pragma unroll
            for (int ai = 0; ai < 2; ++ai)
#pragma unroll
                for (int m = 0; m < 4; ++m) { const int row = row0 + ai * HALF + m * 16;
                    bf16_t* rowp = base + (size_t)row * 1024 + sub * 256 + wc * 32 + 8 * fq;
                    float s1 = 0.f, s2 = 0.f;
#pragma unroll
                    for (int bj = 0; bj < 2; ++bj) { const f32x4 v0 = acc[ai][bj][m][0], v1 = acc[ai][bj][m][1];
                        u32x4 w; w.x = cvt_pk_bf16(gelu_tanh(v0[0]), gelu_tanh(v0[1])); w.y = cvt_pk_bf16(gelu_tanh(v0[2]), gelu_tanh(v0[3]));
                        w.z = cvt_pk_bf16(gelu_tanh(v1[0]), gelu_tanh(v1[1])); w.w = cvt_pk_bf16(gelu_tanh(v1[2]), gelu_tanh(v1[3]));
                        *(u32x4*)(rowp + bj * HALF) = w;
                        if (grp == 4) {
#pragma unroll
                            for (int e = 0; e < 4; ++e) { const float lo = __uint_as_float(w[e] << 16), hi = __uint_as_float(w[e] & 0xffff0000u); s1 += lo + hi; s2 += lo * lo + hi * hi; } } }
                    if (grp == 4) { s1 += __shfl_xor(s1, 16); s1 += __shfl_xor(s1, 32); s2 += __shfl_xor(s2, 16); s2 += __shfl_xor(s2, 32);
                        if (fq == 0) *(f32x2*)(lnst + ((size_t)row * 16 + sub * 4 + wc) * 2) = (f32x2){s1, s2}; } }
        }
    }
};
struct EpiRes {
    static constexpr bool PERM = true, AFTER_DRAIN = false, MIDHOOK = true;
    const float* X; bf16_t* X1b; const PG8_LAS f32x2* tab;
    __device__ __forceinline__ void mid(f32x4 (&acc)[2][2][4][2], int ui, int wr, int fr) const {
#pragma unroll
        for (int ai = 0; ai < 2; ++ai)
#pragma unroll
            for (int m = 0; m < 4; ++m) { const float ratio = tab[ui * BM + ai * HALF + wr * 64 + m * 16 + fr].x;
#pragma unroll
                for (int bj = 0; bj < 2; ++bj)
#pragma unroll
                    for (int n = 0; n < 2; ++n) acc[ai][bj][m][n] = acc[ai][bj][m][n] * ratio; }
    }
    __device__ __forceinline__ void operator()(const f32x4 (&acc)[2][2][4][2], const Unit& u, int ui, int wr, int wc, int fr, int fq) const {
        const int row0 = u.pm * BM + wr * 64 + fr, col0 = u.pn * BM + wc * 32 + 8 * fq;
#pragma unroll
        for (int ai = 0; ai < 2; ++ai)
#pragma unroll
            for (int m = 0; m < 4; ++m) { const size_t off = (size_t)(row0 + ai * HALF + m * 16) * 2048 + col0; const float rsg = tab[ui * BM + ai * HALF + wr * 64 + m * 16 + fr].y;
#pragma unroll
                for (int bj = 0; bj < 2; ++bj) { const f32x4 o0 = *(const f32x4*)(X + off + bj * HALF) + acc[ai][bj][m][0] * rsg, o1 = *(const f32x4*)(X + off + bj * HALF + 4) + acc[ai][bj][m][1] * rsg;
                    u32x4 w; w.x = cvt_pk_bf16(o0[0], o0[1]); w.y = cvt_pk_bf16(o0[2], o0[3]); w.z = cvt_pk_bf16(o1[0], o1[1]); w.w = cvt_pk_bf16(o1[2], o1[3]);
                    *(u32x4*)(X1b + off + bj * HALF) = w; } }
    }
};
struct EpiRelu2 {
    static constexpr bool PERM = true, AFTER_DRAIN = false, MIDHOOK = false;
    bf16_t* O; int ldc;
    __device__ __forceinline__ void operator()(const f32x4 (&acc)[2][2][4][2], const Unit& u, int wr, int wc, int fr, int fq) const {
        const int row0 = u.pm * BM + wr * 64 + fr, col0 = u.pn * BM + wc * 32 + 8 * fq;
#pragma unroll
        for (int ai = 0; ai < 2; ++ai)
#pragma unroll
            for (int m = 0; m < 4; ++m) { bf16_t* rowp = O + (size_t)(row0 + ai * HALF + m * 16) * ldc + col0;
#pragma unroll
                for (int bj = 0; bj < 2; ++bj) { f32x4 v0 = acc[ai][bj][m][0], v1 = acc[ai][bj][m][1];
#pragma unroll
                    for (int e = 0; e < 4; ++e) { const float a = fmaxf(v0[e], 0.f), b = fmaxf(v1[e], 0.f); v0[e] = a * a; v1[e] = b * b; }
                    u32x4 w; w.x = cvt_pk_bf16(v0[0], v0[1]); w.y = cvt_pk_bf16(v0[2], v0[3]); w.z = cvt_pk_bf16(v1[0], v1[1]); w.w = cvt_pk_bf16(v1[2], v1[3]);
                    *(u32x4*)(rowp + bj * HALF) = w; } }
    }
};
struct EpiY16 {
    static constexpr bool PERM = true, AFTER_DRAIN = false, MIDHOOK = false;
    bf16_t* Yo;
    __device__ __forceinline__ void operator()(const f32x4 (&acc)[2][2][4][2], const Unit& u, int wr, int wc, int fr, int fq) const {
        const int row0 = u.pm * BM + wr * 64 + fr, col0 = u.pn * BM + wc * 32 + 8 * fq;
#pragma unroll
        for (int ai = 0; ai < 2; ++ai)
#pragma unroll
            for (int m = 0; m < 4; ++m) { bf16_t* rowp = Yo + (size_t)(row0 + ai * HALF + m * 16) * 2048 + col0;
#pragma unroll
                for (int bj = 0; bj < 2; ++bj) { const f32x4 v0 = acc[ai][bj][m][0], v1 = acc[ai][bj][m][1];
                    u32x4 w; w.x = cvt_pk_bf16(v0[0], v0[1]); w.y = cvt_pk_bf16(v0[2], v0[3]); w.z = cvt_pk_bf16(v1[0], v1[1]); w.w = cvt_pk_bf16(v1[2], v1[3]);
                    *(u32x4*)(rowp + bj * HALF) = w; } }
    }
};

template <class Epi, class Sched, bool ALIGN_EPI = false, bool SP2 = false>
__device__ __forceinline__ void gemm_phase(PG8_LAS unsigned char* lds, const Gemm g, const Sched& S, const Epi& E, const int tid) {
    const int wid = __builtin_amdgcn_readfirstlane(tid >> 6), lane = tid & 63, wr = wid >> 2, wc = wid & 3, fr = lane & 15, fq = lane >> 4;
    const int K = g.K, nt = K / BK;
    unsigned voffA[2], voffB[2];
#pragma unroll
    for (int i = 0; i < 2; ++i) { int R, C; stage_rc(tid * 16 + i * 8192, R, C); const int Rb = Epi::PERM ? ((R & ~31) + perm32(R & 31)) : R;
        voffA[i] = (unsigned)(R * K + C) * 2u; voffB[i] = (unsigned)(Rb * K + C) * 2u; }
    const size_t kstep = (size_t)(BK * 2);
    const size_t hstep = (size_t)HALF * K * 2;
    const size_t tstep = 2 * hstep;
    const unsigned ldsw = (unsigned)wid * 1024u;
    const int aoff = lds_byte(wr * 64 + fr, fq * 8), boff = lds_byte(wc * 32 + fr, fq * 8);
#define PG8_SA(b, h) (((b) * 2 + (h)) * HTB)
#define PG8_SB(b, h) ((4 + (b) * 2 + (h)) * HTB)
#define PG8_STAGE(bufoff, gbase, voff) do { _Pragma("unroll") for (int _i = 0; _i < 2; ++_i) \
        __builtin_amdgcn_global_load_lds((const unsigned*)((const char*)(gbase) + (voff)[_i]), (PG8_LAS unsigned*)(lds + (bufoff) + ldsw + _i * 8192), 16, 0, 0); } while (0)
#define PG8_LDA(dst, b, h) do { _Pragma("unroll") for (int m = 0; m < 4; ++m) _Pragma("unroll") for (int k = 0; k < 2; ++k) dst[m][k] = *(const PG8_LAS bf16x8*)(lds + PG8_SA(b, h) + aoff + m * 2048 + k * 1024); } while (0)
#define PG8_LDB(dst, b, h) do { _Pragma("unroll") for (int n = 0; n < 2; ++n) _Pragma("unroll") for (int k = 0; k < 2; ++k) dst[n][k] = *(const PG8_LAS bf16x8*)(lds + PG8_SB(b, h) + boff + n * 2048 + k * 1024); } while (0)
#define PG8_MMA(ai, bj, At, Bt) do { __builtin_amdgcn_s_setprio(1); _Pragma("unroll") for (int m = 0; m < 4; ++m) _Pragma("unroll") for (int n = 0; n < 2; ++n) _Pragma("unroll") for (int k = 0; k < 2; ++k) \
        acc[ai][bj][m][n] = __builtin_amdgcn_mfma_f32_16x16x32_bf16(Bt[n][k], At[m][k], acc[ai][bj][m][n], 0, 0, 0); __builtin_amdgcn_s_setprio(0); } while (0)
#define PG8_WAIT_V(n) asm volatile("s_waitcnt vmcnt(" #n ")" ::: "memory")
#define PG8_WAIT_L(n) asm volatile("s_waitcnt lgkmcnt(" #n ")" ::: "memory")
#define PG8_BAR __builtin_amdgcn_s_barrier()
#define PG8_SCHED __builtin_amdgcn_sched_barrier(0)
    Unit cur, nxt; int ui = 0;
    if (!S.next(0, cur)) return;
    f32x4 acc[2][2][4][2];
#pragma unroll
    for (int a = 0; a < 2; ++a)
#pragma unroll
        for (int b = 0; b < 2; ++b)
#pragma unroll
            for (int m = 0; m < 4; ++m)
#pragma unroll
                for (int n = 0; n < 2; ++n) acc[a][b][m][n] = (f32x4){0.f, 0.f, 0.f, 0.f};
    bf16x8 At[4][2], B0[2][2], B1[2][2];
    const char* cA = (const char*)g.A + (size_t)cur.pm * tstep; const char* cB = (const char*)g.Bt + (size_t)cur.pn * tstep;
    S.a_ready(cur);
    if constexpr (SP2) {
        PG8_STAGE(PG8_SB(0, 0), cB, voffB); PG8_STAGE(PG8_SB(0, 1), cB + hstep, voffB); PG8_STAGE(PG8_SA(0, 0), cA, voffA); PG8_STAGE(PG8_SA(0, 1), cA + hstep, voffA);
        if (wr == 1) PG8_BAR;
        PG8_WAIT_V(2); PG8_BAR;
        PG8_STAGE(PG8_SB(1, 0), cB + kstep, voffB); PG8_STAGE(PG8_SA(1, 0), cA + kstep, voffA); PG8_STAGE(PG8_SB(1, 1), cB + hstep + kstep, voffB);
        PG8_WAIT_V(6); PG8_BAR;
    } else {
        PG8_STAGE(PG8_SB(0, 0), cB, voffB); PG8_STAGE(PG8_SA(0, 0), cA, voffA); PG8_STAGE(PG8_SB(0, 1), cB + hstep, voffB); PG8_STAGE(PG8_SA(0, 1), cA + hstep, voffA);
        if (wr == 1) PG8_BAR;
        PG8_WAIT_V(4); PG8_BAR;
        PG8_STAGE(PG8_SB(1, 0), cB + kstep, voffB); PG8_STAGE(PG8_SA(1, 0), cA + kstep, voffA); PG8_STAGE(PG8_SB(1, 1), cB + hstep + kstep, voffB);
        PG8_WAIT_V(6); PG8_BAR;
    }
    for (;;) {
        const bool has_next = S.next(ui + 1, nxt);
        const char* nA = has_next ? (const char*)g.A + (size_t)nxt.pm * tstep : cA; const char* nB = has_next ? (const char*)g.Bt + (size_t)nxt.pn * tstep : cB;
        for (int t = 0; t < nt; t += 2) {
            if constexpr (Epi::MIDHOOK) { if (t == (nt >> 1)) E.mid(acc, ui, wr, fr); }
            const bool last = (t == nt - 2);
            const char* a1 = cA + (size_t)(t + 1) * kstep;
            const char* a2 = last ? nA : cA + (size_t)(t + 2) * kstep; const char* b2 = last ? nB : cB + (size_t)(t + 2) * kstep;
            const char* a3 = a2 + kstep; const char* b3 = b2 + kstep;
            if (last && has_next) S.a_ready(nxt);
            if constexpr (SP2) {
            PG8_LDB(B0, 0, 0); PG8_LDB(B1, 0, 1); PG8_SCHED; PG8_LDA(At, 0, 0); PG8_STAGE(PG8_SA(1, 1), a1 + hstep, voffA);
            PG8_WAIT_V(8); PG8_WAIT_L(0); PG8_BAR; PG8_MMA(0, 0, At, B0); PG8_MMA(0, 1, At, B1); PG8_BAR; PG8_SCHED;
            PG8_LDA(At, 0, 1); PG8_STAGE(PG8_SB(0, 0), b2, voffB); PG8_STAGE(PG8_SB(0, 1), b2 + hstep, voffB); PG8_STAGE(PG8_SA(0, 0), a2, voffA);
            PG8_WAIT_V(8); PG8_WAIT_L(0); PG8_BAR; PG8_MMA(1, 0, At, B0); PG8_MMA(1, 1, At, B1); PG8_BAR; PG8_SCHED;
            PG8_LDB(B0, 1, 0); PG8_LDB(B1, 1, 1); PG8_SCHED; PG8_LDA(At, 1, 0); PG8_STAGE(PG8_SA(0, 1), a2 + hstep, voffA);
            PG8_WAIT_V(8); PG8_WAIT_L(0); PG8_BAR; PG8_MMA(0, 0, At, B0); PG8_MMA(0, 1, At, B1); PG8_BAR; PG8_SCHED;
            PG8_LDA(At, 1, 1); PG8_STAGE(PG8_SB(1, 0), b3, voffB); PG8_STAGE(PG8_SB(1, 1), b3 + hstep, voffB); PG8_STAGE(PG8_SA(1, 0), a3, voffA);
            PG8_WAIT_V(8); PG8_WAIT_L(0); PG8_BAR; PG8_MMA(1, 0, At, B0); PG8_MMA(1, 1, At, B1); PG8_BAR; PG8_SCHED;
            } else {
            PG8_LDB(B0, 0, 0); PG8_SCHED; PG8_LDA(At, 0, 0); PG8_STAGE(PG8_SA(1, 1), a1 + hstep, voffA);
            PG8_WAIT_L(8); PG8_BAR; PG8_WAIT_L(0); PG8_MMA(0, 0, At, B0); PG8_BAR; PG8_SCHED;
            PG8_LDB(B1, 0, 1); PG8_STAGE(PG8_SB(0, 0), b2, voffB);
            PG8_BAR; PG8_WAIT_L(0); PG8_MMA(0, 1, At, B1); PG8_BAR;
            PG8_LDA(At, 0, 1); PG8_STAGE(PG8_SA(0, 0), a2, voffA);
            PG8_BAR; PG8_WAIT_L(0); PG8_MMA(1, 0, At, B0); PG8_BAR; PG8_SCHED;
            PG8_STAGE(PG8_SB(0, 1), b2 + hstep, voffB);
            PG8_WAIT_V(6); PG8_BAR; PG8_MMA(1, 1, At, B1); PG8_BAR;
            PG8_LDB(B0, 1, 0); PG8_SCHED; PG8_LDA(At, 1, 0); PG8_STAGE(PG8_SA(0, 1), a2 + hstep, voffA);
            PG8_WAIT_L(8); PG8_BAR; PG8_WAIT_L(0); PG8_MMA(0, 0, At, B0); PG8_BAR; PG8_SCHED;
            PG8_LDB(B1, 1, 1); PG8_STAGE(PG8_SB(1, 0), b3, voffB);
            PG8_BAR; PG8_WAIT_L(0); PG8_MMA(0, 1, At, B1); PG8_BAR;
            PG8_LDA(At, 1, 1); PG8_STAGE(PG8_SA(1, 0), a3, voffA);
            PG8_BAR; PG8_WAIT_L(0); PG8_MMA(1, 0, At, B0); PG8_BAR; PG8_SCHED;
            PG8_STAGE(PG8_SB(1, 1), b3 + hstep, voffB);
            PG8_WAIT_V(6); PG8_BAR; PG8_MMA(1, 1, At, B1); PG8_BAR;
            }
        }
        if constexpr (ALIGN_EPI) { if (wr == 0) PG8_BAR; }
        if constexpr (!Epi::AFTER_DRAIN) { if constexpr (Epi::MIDHOOK) E(acc, cur, ui, wr, wc, fr, fq); else E(acc, cur, wr, wc, fr, fq); S.done(cur); }
        if (!has_next) break;
#pragma unroll
        for (int a = 0; a < 2; ++a)
#pragma unroll
            for (int b = 0; b < 2; ++b)
#pragma unroll
                for (int m = 0; m < 4; ++m)
#pragma unroll
                    for (int n = 0; n < 2; ++n) acc[a][b][m][n] = (f32x4){0.f, 0.f, 0.f, 0.f};
        cur = nxt; cA = nA; cB = nB; ++ui;
        if constexpr (ALIGN_EPI) { if (wr == 1) PG8_BAR; }
    }
    PG8_WAIT_V(0);
    if constexpr (!ALIGN_EPI) { if (wr == 0) PG8_BAR; }
    PG8_BAR;
    if constexpr (Epi::AFTER_DRAIN) { E.fused(acc, cur, wr, wc, fr, fq, lds, wid, lane); S.done(cur); }
#undef PG8_SA
#undef PG8_SB
#undef PG8_STAGE
#undef PG8_LDA
#undef PG8_LDB
#undef PG8_MMA
#undef PG8_WAIT_V
#undef PG8_WAIT_L
#undef PG8_BAR
#undef PG8_SCHED
}
}
namespace att {
using bf16 = __hip_bfloat16;
typedef short bf16x8 __attribute__((ext_vector_type(8)));
typedef short s16x4 __attribute__((ext_vector_type(4)));
typedef float f32x16 __attribute__((ext_vector_type(16)));
typedef float f32x4 __attribute__((ext_vector_type(4)));
typedef unsigned u32x4 __attribute__((ext_vector_type(4)));
constexpr int D = 128, SEQ = 4096, OP = 2048;
constexpr float SCALE = 0.08838834764831845f, THR = 8.f;
constexpr int NW = 8, QBLK = 32, KVBLK = 64, QB = NW * QBLK;
constexpr int SHM_V = KVBLK * D * 2, SHM_K = KVBLK * D * 2;
constexpr int OFF_WS = 2 * SHM_V + 2 * SHM_K, OFF_BIAS = OFF_WS + NW * 64 * 4, BIAS_BYTES = SEQ * 4, LDS_BYTES = OFF_BIAS + 2 * BIAS_BYTES;

#define KSWZ(row, colB) ((row) * 256 + ((colB) ^ (((row) & 7) << 4)))
#define SBAR() __builtin_amdgcn_sched_barrier(0)
__device__ __forceinline__ int v_st(int k, int c) { const int kk = (k & ~0xC) | ((k & 4) << 1) | ((k & 8) >> 1); return ((kk >> 3) * 4 + (c >> 5)) * 512 + ((kk & 7) * 32 + (c & 31)) * 2; }
__device__ __forceinline__ int v_rd_base(int lane) { return ((lane & 3) << 3) | (((lane >> 2) & 3) << 6) | (((lane >> 4) & 1) << 5) | (((lane >> 5) & 1) << 8); }
constexpr int v_rd_off(int d0, int ks, int half) { return d0 * 512 + ks * 4096 + half * 2048; }
__device__ __forceinline__ int crow(int r, int hi) { return (r & 3) + 8 * (r >> 2) + 4 * hi; }
__device__ __forceinline__ unsigned cvtpk(float lo, float hi) { unsigned r; asm volatile("v_cvt_pk_bf16_f32 %0, %1, %2" : "=v"(r) : "v"(lo), "v"(hi)); return r; }
__device__ __forceinline__ bf16x8 load8(const bf16* p) { return *reinterpret_cast<const bf16x8*>(p); }
__device__ __forceinline__ bf16x8 ldg16(const char* sb, unsigned off) { return *reinterpret_cast<const bf16x8*>(sb + off); }
__device__ __forceinline__ void mask_tile(f32x16& p0, f32x16& p1, int dq, unsigned W) {
    const float NEG = -__builtin_inff();
#pragma unroll
    for (int r = 0; r < 16; ++r) {
        const int c = (r & 3) + 8 * (r >> 2);
        if ((unsigned)(dq - c) >= W) p0[r] = NEG;
        if ((unsigned)(dq - c - 32) >= W) p1[r] = NEG;
    }
}
__device__ __forceinline__ void partialSM(f32x16& p0, f32x16& p1, float& m_reg, float& mn, float& alpha) {
    float pmax = p0[0]; for (int r = 1; r < 16; ++r) pmax = fmaxf(pmax, p0[r]); for (int r = 0; r < 16; ++r) pmax = fmaxf(pmax, p1[r]);
    { auto rr = __builtin_amdgcn_permlane32_swap(__float_as_uint(pmax), __float_as_uint(pmax), false, false);
      pmax = fmaxf(__uint_as_float(rr[0]), __uint_as_float(rr[1])); }
    constexpr float C2 = 1.4426950408889634f * SCALE;
    if (__builtin_expect(__all((pmax - m_reg) * SCALE <= THR), 1)) { mn = m_reg; alpha = 1.f; }
    else { mn = fmaxf(m_reg, pmax); alpha = __builtin_amdgcn_exp2f((m_reg - mn) * C2); m_reg = mn; }
    const float mnL = -mn * C2;
    for (int r = 0; r < 16; ++r) p0[r] = fmaf(p0[r], C2, mnL); for (int r = 0; r < 16; ++r) p1[r] = fmaf(p1[r], C2, mnL);
    for (int r = 0; r < 16; ++r) p0[r] = __builtin_amdgcn_exp2f(p0[r]);
}
__device__ __forceinline__ void finishSM(f32x16& p0, f32x16& p1, float alpha, float& l_reg, bf16x8& pa0, bf16x8& pa1, bf16x8& pa2, bf16x8& pa3) {
    for (int r = 0; r < 16; ++r) p1[r] = __builtin_amdgcn_exp2f(p1[r]);
    float ps = 0; for (int r = 0; r < 16; ++r) ps += p0[r]; for (int r = 0; r < 16; ++r) ps += p1[r];
    { auto rr = __builtin_amdgcn_permlane32_swap(__float_as_uint(ps), __float_as_uint(ps), false, false);
      ps = __uint_as_float(rr[0]) + __uint_as_float(rr[1]); }
    l_reg = l_reg * alpha + ps;
#define PK4(P, B_, OUT) do { unsigned a0 = cvtpk(P[B_+0], P[B_+1]), a1 = cvtpk(P[B_+2], P[B_+3]);                          \
        unsigned b0 = cvtpk(P[B_+4], P[B_+5]), b1 = cvtpk(P[B_+6], P[B_+7]);                                             \
        auto r0 = __builtin_amdgcn_permlane32_swap(a0, b0, false, false); auto r1 = __builtin_amdgcn_permlane32_swap(a1, b1, false, false); \
        u32x4 w = {r0[0], r1[0], r0[1], r1[1]}; OUT = *reinterpret_cast<bf16x8*>(&w); } while (0)
    PK4(p0, 0, pa0); PK4(p0, 8, pa1); PK4(p1, 0, pa2); PK4(p1, 8, pa3);
#undef PK4
}
template <int KB>
__device__ __forceinline__ void qkt(f32x16& p0, f32x16& p1, const char* K_lds, int r32, int hi, const bf16x8* qr, const float* bp) {
#pragma unroll
    for (int g = 0; g < 4; ++g) { const f32x4 a = *(const f32x4*)(bp + 8 * g), b = *(const f32x4*)(bp + 32 + 8 * g);
        p0[4 * g] = a[0]; p0[4 * g + 1] = a[1]; p0[4 * g + 2] = a[2]; p0[4 * g + 3] = a[3];
        p1[4 * g] = b[0]; p1[4 * g + 1] = b[1]; p1[4 * g + 2] = b[2]; p1[4 * g + 3] = b[3]; }
    const char* kb[4];
#pragma unroll
    for (int dd = 0; dd < 4; ++dd) kb[dd] = K_lds + KB * SHM_K + KSWZ(r32, (dd * 16 + hi * 8) * 2);
#pragma unroll
    for (int d0 = 0; d0 < 8; ++d0) { const char* a = kb[d0 & 3] + (d0 >> 2) * 128;
        bf16x8 b0 = *reinterpret_cast<const bf16x8*>(a);
        bf16x8 b1 = *reinterpret_cast<const bf16x8*>(a + 32 * 256);
        p0 = __builtin_amdgcn_mfma_f32_32x32x16_bf16(b0, qr[d0], p0, 0, 0, 0);
        p1 = __builtin_amdgcn_mfma_f32_32x32x16_bf16(b1, qr[d0], p1, 0, 0, 0); }
}
#define TRRD(dst, off) asm volatile("ds_read_b64_tr_b16 %0, %1 offset:%2" : "=&v"(dst) : "v"(vb0), "i"(off) : "memory")
#define PV_D0(VB, d0, oo) do { s16x4 l0, l1, l2, l3, h0, h1, h2, h3; constexpr int b_ = (VB) * SHM_V + v_rd_off(d0, 0, 0);   \
        TRRD(l0, b_); TRRD(h0, b_ + 2048); TRRD(l1, b_ + 4096); TRRD(h1, b_ + 6144); TRRD(l2, b_ + 8192); TRRD(h2, b_ + 10240); TRRD(l3, b_ + 12288); TRRD(h3, b_ + 14336); \
        asm volatile("s_waitcnt lgkmcnt(0)" ::: "memory"); SBAR();                                                          \
        oo = __builtin_amdgcn_mfma_f32_32x32x16_bf16(pa0, (bf16x8){l0[0], l0[1], l0[2], l0[3], h0[0], h0[1], h0[2], h0[3]}, oo, 0, 0, 0);   \
        oo = __builtin_amdgcn_mfma_f32_32x32x16_bf16(pa1, (bf16x8){l1[0], l1[1], l1[2], l1[3], h1[0], h1[1], h1[2], h1[3]}, oo, 0, 0, 0);   \
        oo = __builtin_amdgcn_mfma_f32_32x32x16_bf16(pa2, (bf16x8){l2[0], l2[1], l2[2], l2[3], h2[0], h2[1], h2[2], h2[3]}, oo, 0, 0, 0);   \
        oo = __builtin_amdgcn_mfma_f32_32x32x16_bf16(pa3, (bf16x8){l3[0], l3[1], l3[2], l3[3], h3[0], h3[1], h3[2], h3[3]}, oo, 0, 0, 0); } while (0)
template <int VB>
__device__ __forceinline__ void pv_tile(f32x16* o, int vb0, bf16x8 pa0, bf16x8 pa1, bf16x8 pa2, bf16x8 pa3) {
    PV_D0(VB, 0, o[0]); PV_D0(VB, 1, o[1]); PV_D0(VB, 2, o[2]); PV_D0(VB, 3, o[3]);
}
template <int VB, int DA>
__device__ __forceinline__ void pv_half(f32x16* o2, int vb0, bf16x8 pa0, bf16x8 pa1, bf16x8 pa2, bf16x8 pa3) {
    PV_D0(VB, DA, o2[0]); PV_D0(VB, DA + 1, o2[1]);
}

__device__ __forceinline__ float rowsum16(const float (&sq)[16], int r32) {
    const bool b4 = r32 & 16, b3 = r32 & 8, b2 = r32 & 4, b1 = r32 & 2;
    float t[8], u[4], v[2];
#pragma unroll
    for (int j = 0; j < 8; ++j) { const float mine = b4 ? sq[8 + j] : sq[j], oth = b4 ? sq[j] : sq[8 + j]; t[j] = mine + __shfl_xor(oth, 16); }
#pragma unroll
    for (int j = 0; j < 4; ++j) { const float mine = b3 ? t[4 + j] : t[j], oth = b3 ? t[j] : t[4 + j]; u[j] = mine + __shfl_xor(oth, 8); }
#pragma unroll
    for (int j = 0; j < 2; ++j) { const float mine = b2 ? u[2 + j] : u[j], oth = b2 ? u[j] : u[2 + j]; v[j] = mine + __shfl_xor(oth, 4); }
    const float mine = b1 ? v[1] : v[0], oth = b1 ? v[0] : v[1]; float w = mine + __shfl_xor(oth, 2);
    return w + __shfl_xor(w, 1);
}
struct BlockRef { const bf16* Q; const bf16* K; const bf16* V; bf16* O; const float* NB; float* SS; int P0; };
struct Seam { bf16x8 qr[8]; bf16x8 st0, st1; };
#define VMW() asm volatile("s_waitcnt vmcnt(0)" ::: "memory")
#define VMWN(n) asm volatile("s_waitcnt vmcnt(%0)" :: "i"(n) : "memory")
#define SLOAD2(p, k0) do { const char* b_ = (const char*)(p) + (size_t)(k0) * (D * 2); S.st0 = ldg16(b_, voff); S.st1 = ldg16(b_ + 32 * D * 2, voff); } while (0)
#define SWRITE_K(bf) do { *(bf16x8*)(K_lds + (bf) * SHM_K + kws) = S.st0; *(bf16x8*)(K_lds + (bf) * SHM_K + kws + 32 * 256) = S.st1; } while (0)
#define SWRITE_V(bf) do { *(bf16x8*)(V_lds + (bf) * SHM_V + vst0) = S.st0; *(bf16x8*)(V_lds + (bf) * SHM_V + vst1) = S.st1; } while (0)
__device__ __forceinline__ void bias_to_lds(const float* NB, char* lds, int reg, const int tid) {
    const f32x4 a = *(const f32x4*)(NB + tid * 4), b = *(const f32x4*)(NB + 2048 + tid * 4);
    float* dst = (float*)(lds + OFF_BIAS + reg * BIAS_BYTES);
    *(f32x4*)(dst + tid * 4) = a; *(f32x4*)(dst + 2048 + tid * 4) = b;
}
__device__ __forceinline__ void prime(const BlockRef& cur, char* lds, Seam& S, const int tid) {
    const int wid = __builtin_amdgcn_readfirstlane(tid >> 6), lane = tid & 63, r32 = lane & 31, hi = lane >> 5;
    const int sr = tid >> 4, sc = (tid & 15) * 8, kws = KSWZ(sr, sc * 2); char* K_lds = lds + 2 * SHM_V; const unsigned voff = (unsigned)(sr * D + sc) * 2u;
#pragma unroll
    for (int d0 = 0; d0 < 8; ++d0) S.qr[d0] = load8(cur.Q + (size_t)(wid * QBLK + r32) * D + d0 * 16 + hi * 8);
    const int kb0 = ((cur.P0 + QB - 1) / KVBLK) * KVBLK;
    SLOAD2(cur.K, kb0);
    bias_to_lds(cur.NB, lds, 0, tid);
    VMW(); SWRITE_K(0); SBAR(); SLOAD2(cur.V, kb0);
    __syncthreads();
}
__device__ __forceinline__ void block(const BlockRef& cur, const BlockRef& nxt, char* lds, Seam& S, int par, const int tid) {
    const int wid = __builtin_amdgcn_readfirstlane(tid >> 6), lane = tid & 63, r32 = lane & 31, hi = lane >> 5;
    constexpr int W = SEQ;
    const int NT = (cur.P0 + QB - 1) / KVBLK + 1;
    const int qlo = cur.P0 + wid * QBLK, qm = qlo + r32 - 4 * hi;
    char* V_lds = lds; char* K_lds = lds + 2 * SHM_V;
    float* ws = (float*)(lds + OFF_WS) + wid * 64; float* li_l = ws, * al_l = ws + 32;
    const float* bl = (const float*)(lds + OFF_BIAS + par * BIAS_BYTES) + 4 * hi;
    float m_reg = -1e30f, l_reg = 0; f32x16 o[4] = {};
    const int sr = tid >> 4, sc = (tid & 15) * 8, vst0 = v_st(sr, sc), vst1 = v_st(32 + sr, sc), kws = KSWZ(sr, sc * 2); const unsigned voff = (unsigned)(sr * D + sc) * 2u;
    const int vb0 = (int)(uintptr_t)V_lds + v_rd_base(lane);
    const bf16* Kh = cur.K; const bf16* Vh = cur.V;
#define RESC(a) do { if (__any((a) < 1.f)) { if (hi == 0) al_l[r32] = (a); asm volatile("s_waitcnt lgkmcnt(0)" ::: "memory");              \
                     for (int d_ = 0; d_ < 4; ++d_) for (int r = 0; r < 16; ++r) o[d_][r] *= al_l[crow(r, hi)]; } } while (0)
#define KBASE(t) ((NT - 1 - (t)) * KVBLK)
#define MASKT(P0_, P1_, t) do { const int kb_ = KBASE(t); if (kb_ + KVBLK - 1 > qlo) mask_tile(P0_, P1_, qm - kb_, (unsigned)W); } while (0)
    f32x16 pA0, pA1, pB0, pB1; float mnA, mnB, alA, alB; bf16x8 pa0, pa1, pa2, pa3;
    VMW(); SWRITE_V(0); SBAR();
    SLOAD2(Kh, KBASE(1));
    SBAR(); qkt<0>(pA0, pA1, K_lds, r32, hi, S.qr, bl + KBASE(0));
    VMW(); SWRITE_K(1); SBAR(); SLOAD2(Vh, KBASE(1));
    MASKT(pA0, pA1, 0); partialSM(pA0, pA1, m_reg, mnA, alA);
    VMW(); SWRITE_V(1); SBAR(); if (NT > 2) SLOAD2(Kh, KBASE(2));
    __syncthreads();
#define HALF_STEP(PX0, PX1, mnX, alX, PY0, PY1, alY, t, KB, VB, SB) do {                                                      \
        SBAR(); qkt<KB>(PX0, PX1, K_lds, r32, hi, S.qr, bl + KBASE(t));                                                      \
        finishSM(PY0, PY1, alY, l_reg, pa0, pa1, pa2, pa3); SBAR();                                                           \
        if ((t) + 1 < NT) { VMW(); SWRITE_K(SB); SBAR(); SLOAD2(Vh, KBASE((t) + 1)); SBAR(); }                                \
        pv_tile<VB>(o, vb0, pa0, pa1, pa2, pa3); MASKT(PX0, PX1, (t)); partialSM(PX0, PX1, m_reg, mnX, alX);                  \
        __syncthreads();                                                                                                      \
        if ((t) + 1 < NT) { VMW(); SWRITE_V(SB); SBAR(); if ((t) + 2 < NT) SLOAD2(Kh, KBASE((t) + 2)); }                      \
        RESC(alX); __syncthreads(); } while (0)
    for (int t = 1; t + 1 < NT; t += 2) {
        HALF_STEP(pB0, pB1, mnB, alB, pA0, pA1, alA, t, 1, 0, 0);
        HALF_STEP(pA0, pA1, mnA, alA, pB0, pB1, alB, t + 1, 0, 1, 1);
    }
    SBAR(); qkt<1>(pB0, pB1, K_lds, r32, hi, S.qr, bl + KBASE(NT - 1)); SBAR();
    const int kbn = ((nxt.P0 + QB - 1) / KVBLK) * KVBLK;
    SLOAD2(nxt.K, kbn); SBAR();
#pragma unroll
    for (int d0 = 0; d0 < 8; ++d0) S.qr[d0] = load8(nxt.Q + (size_t)(wid * QBLK + r32) * D + d0 * 16 + hi * 8);
    SBAR();
    finishSM(pA0, pA1, alA, l_reg, pa0, pa1, pa2, pa3); SBAR();
    pv_tile<0>(o, vb0, pa0, pa1, pa2, pa3);
    MASKT(pB0, pB1, NT - 1); partialSM(pB0, pB1, m_reg, mnB, alB); __syncthreads(); RESC(alB);
    finishSM(pB0, pB1, alB, l_reg, pa0, pa1, pa2, pa3); SBAR(); pv_tile<1>(o, vb0, pa0, pa1, pa2, pa3);
    SBAR(); VMWN(8); SWRITE_K(0); SBAR(); SLOAD2(nxt.V, kbn); SBAR();
    if (hi == 0) li_l[r32] = l_reg; asm volatile("s_waitcnt lgkmcnt(0)" ::: "memory");
    float rli[16];
#pragma unroll
    for (int r = 0; r < 16; ++r) rli[r] = __builtin_amdgcn_rcpf(li_l[crow(r, hi)]);
    char* Owb = (char*)(cur.O + (size_t)(wid * QBLK) * OP); char* ssb = (char*)(cur.SS + (size_t)(wid * QBLK) * 8);
    const unsigned olane = (unsigned)((4 * hi) * OP + r32) * 2u, slane = (unsigned)(4 * hi * 8) * 4u;
#pragma unroll
    for (int r = 0; r < 16; ++r) { const int rc = (r & 3) + 8 * (r >> 2); float sq = 0.f;
#pragma unroll
        for (int d0 = 0; d0 < 4; ++d0) { const float v = o[d0][r] * rli[r];
            const float vn = __shfl_xor(v, 1); const unsigned w = cvtpk(v, vn); const float vr = __uint_as_float(w << 16); sq += vr * vr;
            if ((r32 & 1) == 0) *(unsigned*)(Owb + (size_t)(rc * OP + d0 * 32) * 2 + olane) = w; }
        sq += __shfl_xor(sq, 1); sq += __shfl_xor(sq, 2); sq += __shfl_xor(sq, 4); sq += __shfl_xor(sq, 8); sq += __shfl_xor(sq, 16);
        if (r32 == 0) *(float*)(ssb + (size_t)(rc * 8) * 4 + slane) = sq;
        asm volatile("" ::: "memory"); }
    bias_to_lds(nxt.NB, lds, par ^ 1, tid);
    __syncthreads();
#undef RESC
#undef KBASE
#undef MASKT
#undef HALF_STEP
}
}
namespace cg = cooperative_groups;
constexpr int NWAVES = 8;
constexpr int BATCH = 4, SEQ = 4096, DM = 2048, NH = 8, HD = 128, DA = 1024, DG = 1024, DFF = 8192, NIN = 5128, NIN2 = 5120, CHUNK = 128;
constexpr int M = BATCH * SEQ;
constexpr float EPS = 1e-6f;
constexpr size_t MiB = 1u << 20;
constexpr size_t WS_SSA = 1 * MiB, WS_SSG = 2 * MiB;
constexpr size_t WS_LF = 4 * MiB, WS_NB = 5 * MiB, WS_WSB = 6 * MiB, WS_LNST = 8 * MiB;
constexpr size_t WS_W1 = 12 * MiB, WS_WO = 32 * MiB, WS_WF1 = 40 * MiB, WS_X1B = 72 * MiB;
constexpr size_t WS_Y16 = 8 * MiB;
constexpr size_t WS_WF2 = 136 * MiB;
constexpr size_t WS_HID = 168 * MiB;
constexpr size_t WS_XN = 168 * MiB, WS_Q = 232 * MiB, WS_K = 264 * MiB, WS_V = 296 * MiB, WS_U = 328 * MiB, WS_YG = 360 * MiB, WS_ATT = 392 * MiB, WS_GM = 424 * MiB, WS_END = 456 * MiB;
constexpr int LDS_BYTES = 147456;
#define LAS __attribute__((address_space(3)))
typedef unsigned short bf16;
typedef unsigned v4u __attribute__((ext_vector_type(4)));
typedef unsigned v2u __attribute__((ext_vector_type(2)));
typedef float f32x4 __attribute__((ext_vector_type(4)));
typedef float f32x2 __attribute__((ext_vector_type(2)));
typedef short bf16x8 __attribute__((ext_vector_type(8)));
#define LDS_WAIT() asm volatile("s_waitcnt lgkmcnt(0)" ::: "memory")
__device__ __forceinline__ unsigned f2bf(float f) { unsigned u = __builtin_bit_cast(unsigned, f); return (u + 0x7fffu + ((u >> 16) & 1u)) >> 16; }
__device__ __forceinline__ unsigned pk2(float lo, float hi) { return f2bf(lo) | (f2bf(hi) << 16); }
__device__ __forceinline__ float bf_lo(unsigned w) { return __uint_as_float(w << 16); }
__device__ __forceinline__ float bf_hi(unsigned w) { return __uint_as_float(w & 0xffff0000u); }
__device__ __forceinline__ float wave_sum(float v) {
#pragma unroll
    for (int o = 1; o < 64; o <<= 1) v += __shfl_xor(v, o);
    return v;
}
__device__ __forceinline__ void p0_transpose_item(const float* W, int ldw, int K, int nblk, bf16* WT, int row_off, const float* gk, LAS float* scr, int item, int lane) {
    const int kb = item / nblk, nb = item % nblk, k0 = 64 * kb, n0 = 64 * nb;
    const int r = lane >> 4, c = lane & 15;
    f32x4 v[16];
#pragma unroll
    for (int i = 0; i < 16; ++i) v[i] = *(const f32x4*)(W + (size_t)(k0 + 4 * i + r) * ldw + n0 + 4 * c);
#pragma unroll
    for (int i = 0; i < 16; ++i) { const int k = 4 * i + r; f32x4 t = v[i]; if (gk) t = t * gk[k0 + k];
        *(LAS f32x4*)(scr + k * 64 + ((4 * c) ^ (((k >> 3) & 7) << 2))) = t; }
    LDS_WAIT(); asm volatile("" ::: "memory");
    const int nrow = lane >> 3, kc = lane & 7;
#pragma unroll
    for (int j = 0; j < 8; ++j) { const int n = 8 * j + nrow; const LAS float* sp = scr + (8 * kc) * 64 + (n ^ (kc << 2));
        v4u o; o.x = pk2(sp[0 * 64], sp[1 * 64]); o.y = pk2(sp[2 * 64], sp[3 * 64]); o.z = pk2(sp[4 * 64], sp[5 * 64]); o.w = pk2(sp[6 * 64], sp[7 * 64]);
        *(v4u*)(WT + (size_t)(row_off + n0 + n) * K + k0 + 8 * kc) = o; }
    LDS_WAIT(); asm volatile("" ::: "memory");
}

#define XB_TMO      128
#define XB_XCNT(j)  (256  + 64 * (j))
#define XB_XSUB(j)  (1280 + 64 * (j))
#define XB_XGEN(j)  (2304 + 64 * (j))
#define XB_TOP      3328
#define XB_TOPGEN   3392
#define XCD_BAR_WORDS 3456
#define XB_SPIN_CAP (1u << 18)

__device__ __forceinline__ unsigned xb_ld(unsigned* p)              { return __hip_atomic_load(p, __ATOMIC_RELAXED, __HIP_MEMORY_SCOPE_AGENT); }
__device__ __forceinline__ unsigned xb_add(unsigned* p, unsigned v) { return __hip_atomic_fetch_add(p, v, __ATOMIC_RELAXED, __HIP_MEMORY_SCOPE_AGENT); }
__device__ __forceinline__ unsigned xb_xcc_id() { return (unsigned)__builtin_amdgcn_s_getreg((3 << 11) | 20) & 0xFu; }
#define XB_SPIN(cond, bar) do { unsigned _sp = 0; while (cond) { __builtin_amdgcn_s_sleep(1); \
    if ((++_sp & 255u) == 0u) { if (xb_ld(&(bar)[XB_TMO])) break; if (_sp > XB_SPIN_CAP) { atomicAdd(&(bar)[XB_TMO], 1u); break; } } } } while (0)

struct XcdBarrier {
    unsigned* bar; unsigned x;
    volatile LAS unsigned* st;
};

__device__ __forceinline__ XcdBarrier xcd_barrier_post(unsigned* bar, volatile LAS unsigned* st, const int tid) {
    XcdBarrier b; b.bar = bar; b.x = xb_xcc_id(); b.st = st;
    if (tid == 0) (void)xb_add(&bar[XB_XCNT(b.x)], 1u);
    return b;
}
__device__ __forceinline__ void xcd_barrier_complete(unsigned* bar, unsigned x, unsigned& nloc, unsigned& nx) {
    const unsigned G = gridDim.x * gridDim.y * gridDim.z;
    unsigned sum, cnt, mine, sp = 0u;
    for (;;) {
        sum = 0u; cnt = 0u; mine = 0u;
#pragma unroll
        for (unsigned j = 0; j < 16; ++j) { const unsigned c = xb_ld(&bar[XB_XCNT(j)]); sum += c; cnt += (c > 0u) ? 1u : 0u; mine = (j == x) ? c : mine; }
        if (sum == G) break;
        __builtin_amdgcn_s_sleep(1);
        if ((++sp & 255u) == 0u) { if (xb_ld(&bar[XB_TMO])) break; if (sp > XB_SPIN_CAP) { atomicAdd(&bar[XB_TMO], 1u); break; } }
    }
    nloc = mine > 0u ? mine : 1u; nx = cnt > 0u ? cnt : 1u;
}

__device__ __forceinline__ void xcd_barrier(const XcdBarrier& b, const int tid) {
    asm volatile("s_waitcnt vmcnt(0)" ::: "memory");
    __syncthreads();
    if (tid == 0) {
        unsigned* bar = b.bar;
        __builtin_amdgcn_s_waitcnt(0);
        unsigned nloc = b.st[0], nx = b.st[1];
        if (nloc == 0u) { xcd_barrier_complete(bar, b.x, nloc, nx); b.st[0] = nloc; b.st[1] = nx; }
        const unsigned old = xb_add(&bar[XB_XSUB(b.x)], 1u);
        const unsigned gen = old / nloc;
        if (old + 1u == (gen + 1u) * nloc) {
            __builtin_amdgcn_fence(__ATOMIC_RELEASE, "agent");
            asm volatile("s_waitcnt vmcnt(0)" ::: "memory");
            const unsigned og = xb_add(&bar[XB_TOP], 1u);
            const unsigned tg = og / nx;
            if (og + 1u == (tg + 1u) * nx) xb_add(&bar[XB_TOPGEN], 1u);
            else XB_SPIN(xb_ld(&bar[XB_TOPGEN]) == tg, bar);
            __builtin_amdgcn_fence(__ATOMIC_ACQUIRE, "agent");
            xb_add(&bar[XB_XGEN(b.x)], 1u);
            asm volatile("s_waitcnt vmcnt(0)" ::: "memory");
        } else {
            XB_SPIN(xb_ld(&bar[XB_XGEN(b.x)]) == gen, bar);
            __builtin_amdgcn_fence(__ATOMIC_ACQUIRE, "agent");
            asm volatile("s_waitcnt vmcnt(0)" ::: "memory");
        }
    }
    __syncthreads();
}

struct Args { const float* in[15]; float* out; unsigned char* ws; };
__device__ __forceinline__ int lane_id_fresh() { int z = 0; asm volatile("" : "+v"(z)); return __builtin_amdgcn_mbcnt_hi(~0u, __builtin_amdgcn_mbcnt_lo(~0u, z)); }
__device__ __forceinline__ att::BlockRef mk_block_ref(int LL, int ps, const bf16* Qb, const bf16* Kb, const bf16* Vb, bf16* MG, const float* NB, float* SSA) {
    constexpr int NQB = SEQ / 256, NX = NQB / 2;
    const int bh = LL / NX, xx = LL % NX, qb = ps ? NQB - 1 - xx : xx, b = bh / NH, h = bh % NH; att::BlockRef r;
    r.Q = (const att::bf16*)Qb + ((size_t)bh * SEQ + (size_t)qb * 256) * HD; r.K = (const att::bf16*)Kb + (size_t)bh * SEQ * HD; r.V = (const att::bf16*)Vb + (size_t)bh * SEQ * HD;
    const size_t row0 = (size_t)b * SEQ + (size_t)qb * 256;
    r.O = (att::bf16*)MG + row0 * DM + h * HD; r.NB = NB + (size_t)bh * SEQ; r.SS = SSA + row0 * 8 + h; r.P0 = qb * 256; return r;
}

__global__ void __launch_bounds__(NWAVES * 64, 2) mk_fwd(Args args) {
    extern __shared__ __attribute__((aligned(16))) unsigned char lds[];
    cg::grid_group grid = cg::this_grid();
    LAS unsigned char* ldsl = (LAS unsigned char*)lds;
    const int wave = __builtin_amdgcn_readfirstlane((int)threadIdx.x >> 6);
#define FRESH_TID const int lane = lane_id_fresh(), tid = wave * 64 + lane; (void)tid
    const int G = gridDim.x; const int bx = blockIdx.x; const int vcu = (G % 8 == 0) ? (bx % 8) * (G / 8) + bx / 8 : bx;
    volatile LAS unsigned* bst = (volatile LAS unsigned*)(ldsl + 131072 + 64);
    if (threadIdx.x == 0) { bst[0] = 0u; bst[1] = 0u; }
    typedef const __attribute__((address_space(4))) Args* ArgP;
#define SEAM() do { FRESH_TID; xcd_barrier(xbar, tid); } while (0)
    ArgP ap = (ArgP)__builtin_amdgcn_kernarg_segment_ptr();
#define PHASE_ARGS FRESH_TID; ArgP A_ = ap; asm volatile("" : "+s"(A_)); unsigned char* ws = A_->ws; (void)ws
#define INP(i) (A_->in[i])
    const int gw = vcu * NWAVES + wave, NGW = G * NWAVES;
    if (ap->ws == nullptr) { grid.sync(); return; }
    XcdBarrier xbar; { FRESH_TID; xbar = xcd_barrier_post((unsigned*)ap->ws, bst, tid); }

#ifndef REPS
#define REPS 0x1111111111ull
#endif
#define REP(k) for (int rep_ = 0; rep_ < (int)((REPS >> (4 * (k))) & 15); ++rep_)
    REP(0) {
        PHASE_ARGS; const float* x = INP(0); const float* g_mix = INP(1); const float* w_in = INP(2); const float* b_f = INP(3); const float* w_s = INP(6); const float* g_att = INP(8); const float* g_gm = INP(9); const float* w_out = INP(10); const float* g_ffn = INP(11); const float* w_ff1 = INP(12); const float* w_ff2 = INP(13);
        bf16* W1t = (bf16*)(ws + WS_W1); bf16* WOt = (bf16*)(ws + WS_WO); bf16* WF1t = (bf16*)(ws + WS_WF1); bf16* WF2t = (bf16*)(ws + WS_WF2); bf16* WSB = (bf16*)(ws + WS_WSB); bf16* XN = (bf16*)(ws + WS_XN); float* LF = (float*)(ws + WS_LF);
        LAS float* scr = (LAS float*)(ldsl + wave * 16384);
        constexpr int I_A = 32 * 48, I_B = 32 * 32, I_O = 32 * 32, I_1 = 32 * 128, I_2 = 128 * 32, NITEMS = I_A + I_B + I_O + I_1 + I_2;
        for (int it = gw; it < NITEMS; it += NGW) {
            int r = it;
            if (r < I_A) { p0_transpose_item(w_in, NIN, DM, 48, W1t, 0, nullptr, scr, r, lane); continue; } r -= I_A;
            if (r < I_B) { p0_transpose_item(w_in + 3080, NIN, DM, 32, W1t, 3072, nullptr, scr, r, lane); continue; } r -= I_B;
            if (r < I_O) { p0_transpose_item(w_out, DM, DM, 32, WOt, 0, (r / 32) * 64 < DA ? g_att : g_gm - DA, scr, r, lane); continue; } r -= I_O;
            if (r < I_1) { p0_transpose_item(w_ff1, DFF, DM, 128, WF1t, 0, g_ffn, scr, r, lane); continue; } r -= I_1;
            p0_transpose_item(w_ff2, DM, DFF, 32, WF2t, 0, nullptr, scr, r, lane);
        }
        for (int i = bx * 512 + tid; i < 8 * 128 * 128 / 8; i += G * 512) { const int e0 = i * 8, t = (e0 >> 7) & 127, s0 = e0 & 127;
            const f32x4 a = *(const f32x4*)(w_s + e0), b = *(const f32x4*)(w_s + e0 + 4); float v[8] = {a[0], a[1], a[2], a[3], b[0], b[1], b[2], b[3]};
#pragma unroll
            for (int e = 0; e < 8; ++e) if (s0 + e > t) v[e] = 0.f;
            v4u o; o.x = pk2(v[0], v[1]); o.y = pk2(v[2], v[3]); o.z = pk2(v[4], v[5]); o.w = pk2(v[6], v[7]); *(v4u*)(WSB + e0) = o; }
        __syncthreads();
        LAS f32x4* WF = (LAS f32x4*)ldsl;
        for (int k = tid; k < DM; k += 512) { const f32x4 a = *(const f32x4*)(w_in + (size_t)k * NIN + 3072), b = *(const f32x4*)(w_in + (size_t)k * NIN + 3076);
            const int q4 = k >> 2, i = k & 3, j = q4 >> 6, l = q4 & 63; WF[((j * 4 + i) * 2 + 0) * 64 + l] = a; WF[((j * 4 + i) * 2 + 1) * 64 + l] = b; }
        __syncthreads();
        f32x4 gv[8];
#pragma unroll
        for (int j = 0; j < 8; ++j) gv[j] = *((const f32x4*)g_mix + lane + 64 * j);
        f32x4 nx[8];
#pragma unroll
        for (int j = 0; j < 8; ++j) nx[j] = *((const f32x4*)(x + (size_t)gw * DM) + lane + 64 * j);
        for (int m = gw; m < M; m += NGW) {
            asm volatile("" ::: "memory");
            f32x4 v[8]; float s = 0.f;
#pragma unroll
            for (int j = 0; j < 8; ++j) { v[j] = nx[j]; s += (v[j][0] * v[j][0] + v[j][1] * v[j][1]) + (v[j][2] * v[j][2] + v[j][3] * v[j][3]); }
            if (m + NGW < M) {
#pragma unroll
                for (int j = 0; j < 8; ++j) nx[j] = *((const f32x4*)(x + (size_t)(m + NGW) * DM) + lane + 64 * j); }
            const float rs = 1.0f / sqrtf(wave_sum(s) * (1.f / DM) + EPS);
            unsigned long long* o8 = (unsigned long long*)(XN + (size_t)m * DM) + lane;
            float zf[8] = {0.f, 0.f, 0.f, 0.f, 0.f, 0.f, 0.f, 0.f};
#pragma unroll
            for (int j = 0; j < 8; ++j) { v[j] = v[j] * rs * gv[j];
                o8[64 * j] = (unsigned long long)pk2(v[j][0], v[j][1]) | ((unsigned long long)pk2(v[j][2], v[j][3]) << 32);
#pragma unroll
                for (int i = 0; i < 4; ++i) { const f32x4 wa = WF[((j * 4 + i) * 2 + 0) * 64 + lane], wb = WF[((j * 4 + i) * 2 + 1) * 64 + lane]; const float hv = v[j][i];
                    zf[0] += hv * wa[0]; zf[1] += hv * wa[1]; zf[2] += hv * wa[2]; zf[3] += hv * wa[3]; zf[4] += hv * wb[0]; zf[5] += hv * wb[1]; zf[6] += hv * wb[2]; zf[7] += hv * wb[3]; } }
            float mine = 0.f;
#pragma unroll
            for (int h = 0; h < 8; ++h) { const float t = wave_sum(zf[h]); if (lane == h) mine = t; }
            if (lane < 8) { const float a = mine + b_f[lane]; const float lf = fminf(a, 0.f) - log1pf(expf(-fabsf(a)));
                const int b = m / SEQ, sidx = m % SEQ; LF[(size_t)(b * NH + lane) * SEQ + sidx] = lf; }
        }
    }
    SEAM();

    REP(1) if (bx < BATCH * NH && wave == 0) {
        PHASE_ARGS; float* LF = (float*)(ws + WS_LF); float* NB = (float*)(ws + WS_NB);
        const float* src = LF + (size_t)bx * SEQ + lane * 64; float* dst = NB + (size_t)bx * SEQ + lane * 64;
        float tot = 0.f;
#pragma unroll
        for (int i = 0; i < 16; ++i) { const f32x4 a = *(const f32x4*)(src + 4 * i); tot += (a[0] + a[1]) + (a[2] + a[3]); }
        float incl = tot;
#pragma unroll
        for (int o = 1; o < 64; o <<= 1) { const float t = __shfl_up(incl, o); if (lane >= o) incl += t; }
        float run = incl - tot;
        const float c = -11.313708498984761f;
#pragma unroll
        for (int i = 0; i < 16; ++i) { const f32x4 a = *(const f32x4*)(src + 4 * i); f32x4 r; run += a[0]; r[0] = run * c; run += a[1]; r[1] = run * c; run += a[2]; r[2] = run * c; run += a[3]; r[3] = run * c; *(f32x4*)(dst + 4 * i) = r; }
    }
    REP(2) {
        PHASE_ARGS; bf16* XN = (bf16*)(ws + WS_XN); bf16* W1t = (bf16*)(ws + WS_W1); bf16* Qb = (bf16*)(ws + WS_Q); bf16* Kb = (bf16*)(ws + WS_K); bf16* Vb = (bf16*)(ws + WS_V); bf16* Ub = (bf16*)(ws + WS_U); bf16* Yb = (bf16*)(ws + WS_YG); float* LNST = (float*)(ws + WS_LNST);
        pg8::Gemm g{XN, W1t, M, NIN2, DM}; pg8::StaticOrder S; S.init(M, NIN2, G, bx);
        pg8::EpiIn E{Qb, Kb, Vb, Ub, Yb, LNST};
        pg8::gemm_phase<pg8::EpiIn, pg8::StaticOrder, true, true>(ldsl, g, S, E, tid);
    }
    SEAM();

    {
        PHASE_ARGS; const float* ln_g = INP(4); const float* ln_b = INP(5); const float* b_s = INP(7);
        bf16* Qb = (bf16*)(ws + WS_Q); bf16* Kb = (bf16*)(ws + WS_K); bf16* Vb = (bf16*)(ws + WS_V); bf16* Ub = (bf16*)(ws + WS_U); bf16* Yb = (bf16*)(ws + WS_YG); bf16* MG = (bf16*)(ws + WS_XN);
        float* NB = (float*)(ws + WS_NB); float* LNST = (float*)(ws + WS_LNST); bf16* WSB = (bf16*)(ws + WS_WSB); float* SSA = (float*)(ws + WS_SSA); float* SSG = (float*)(ws + WS_SSG);
        char* shm = (char*)lds;
        constexpr int NQB = SEQ / 256, NX = NQB / 2, TOTAL = BATCH * NH * NX;
#ifndef ATT_DUP
#define ATT_DUP 1
#endif
#ifndef SYNC_DUP
#define SYNC_DUP 0
#endif
        for (int sd_ = 0; sd_ < SYNC_DUP; ++sd_) SEAM();
        REP(4) {
            const int r32 = lane & 31, hi = lane >> 5, rg = wave & 3, dh = wave >> 2;
            float* st = (float*)(shm + att::OFF_WS);
            char* V_lds = shm;
            const int vb0 = (int)(uintptr_t)V_lds + att::v_rd_base(lane);
            const int sr = tid >> 4, sc = (tid & 15) * 8;
#ifndef GM_DUP
#define GM_DUP 1
#endif
            constexpr int NUNITS = (M / CHUNK) * NH * GM_DUP;
            int hprev = -1;
            bf16x8 pw[8];
            v4u yv[4]; f32x4 sv[2]; unsigned uv[16];
            const unsigned ulane = (unsigned)((4 * hi) * DG + 2 * r32) * 2u, olane = (unsigned)((4 * hi) * DM + 2 * r32) * 2u;
#define GM_LOAD_Y(un) do { const int ch_ = ((un) >> 3) % (M / CHUNK), h_ = (un) & 7; const size_t m_ = (size_t)ch_ * CHUNK;                     \
                _Pragma("unroll") for (int q = 0; q < 4; ++q) yv[q] = *(const v4u*)(Yb + (m_ + q * 32 + sr) * DG + h_ * HD + sc);          \
                const f32x4* p_ = (const f32x4*)(LNST + (m_ + (tid >> 2)) * 32) + 2 * (tid & 3); sv[0] = p_[0]; sv[1] = p_[1]; } while (0)
#define GM_LOAD_U(un) do { const int ch_ = ((un) >> 3) % (M / CHUNK), h_ = (un) & 7; const char* ub_ = (const char*)(Ub + ((size_t)ch_ * CHUNK + rg * 32) * DG + h_ * HD + dh * 64);   \
                _Pragma("unroll") for (int r = 0; r < 16; ++r) { const int rc_ = (r & 3) + 8 * (r >> 2); uv[r] = *(const unsigned*)(ub_ + (size_t)(rc_ * DG) * 2 + ulane); } } while (0)
            int unit = vcu;
            if (unit < NUNITS) { GM_LOAD_Y(unit); GM_LOAD_U(unit); }
            for (; unit < NUNITS; unit += G) {
                const int ch = (unit >> 3) % (M / CHUNK), h = unit & 7; const size_t m0 = (size_t)ch * CHUNK;
                if (h != hprev) { hprev = h;
                    const bf16* wrow = WSB + ((size_t)h * CHUNK + rg * 32 + r32) * CHUNK + 8 * hi;
#pragma unroll
                    for (int i = 0; i < 8; ++i) pw[i] = *(const bf16x8*)(wrow + 16 * i); }
                const f32x4 g0 = *(const f32x4*)(ln_g + h * HD + sc), g1 = *(const f32x4*)(ln_g + h * HD + sc + 4), c0 = *(const f32x4*)(ln_b + h * HD + sc), c1 = *(const f32x4*)(ln_b + h * HD + sc + 4);
                { float s1 = (sv[0][0] + sv[0][2]) + (sv[1][0] + sv[1][2]), s2 = (sv[0][1] + sv[0][3]) + (sv[1][1] + sv[1][3]);
                  s1 += __shfl_xor(s1, 1); s1 += __shfl_xor(s1, 2); s2 += __shfl_xor(s2, 1); s2 += __shfl_xor(s2, 2);
                  if ((tid & 3) == 0) { const float mu = s1 * (1.f / DG), var = fmaxf(s2 * (1.f / DG) - mu * mu, 0.f); st[2 * (tid >> 2)] = mu; st[2 * (tid >> 2) + 1] = 1.0f / sqrtf(var + EPS); } }
                __syncthreads();
                { const int cpos = ((sc >> 6) * 2) * 32 + ((sc & 63) >> 1);
#pragma unroll
                  for (int q = 0; q < 4; ++q) { const int key = q * 32 + sr;
                    const v4u w = yv[q]; const float mu = st[2 * key], rsd = st[2 * key + 1];
                    const float e0 = (bf_lo(w.x) - mu) * rsd * g0[0] + c0[0], e1 = (bf_hi(w.x) - mu) * rsd * g0[1] + c0[1], e2 = (bf_lo(w.y) - mu) * rsd * g0[2] + c0[2], e3 = (bf_hi(w.y) - mu) * rsd * g0[3] + c0[3];
                    const float e4 = (bf_lo(w.z) - mu) * rsd * g1[0] + c1[0], e5 = (bf_hi(w.z) - mu) * rsd * g1[1] + c1[1], e6 = (bf_lo(w.w) - mu) * rsd * g1[2] + c1[2], e7 = (bf_hi(w.w) - mu) * rsd * g1[3] + c1[3];
                    char* vt = V_lds + (q >> 1) * att::SHM_V; const int krow = (q & 1) * 32 + sr;
                    *(v2u*)(vt + att::v_st(krow, cpos)) = (v2u){pk2(e0, e2), pk2(e4, e6)};
                    *(v2u*)(vt + att::v_st(krow, cpos + 32)) = (v2u){pk2(e1, e3), pk2(e5, e7)}; } }
                att::f32x16 o2[2];
                { const char* bb = (const char*)(b_s + h * CHUNK + rg * 32);
#pragma unroll
                  for (int g = 0; g < 4; ++g) { const f32x4 bv = *(const f32x4*)(bb + (size_t)(8 * g) * 4 + (unsigned)(4 * hi) * 4u);
#pragma unroll
                      for (int i = 0; i < 4; ++i) { o2[0][4 * g + i] = bv[i]; o2[1][4 * g + i] = bv[i]; } } }
                __syncthreads();
                const int nu = unit + G;
                if (nu < NUNITS) GM_LOAD_Y(nu);
                if (dh == 0) att::pv_half<0, 0>(o2, vb0, pw[0], pw[1], pw[2], pw[3]); else att::pv_half<0, 2>(o2, vb0, pw[0], pw[1], pw[2], pw[3]);
                if (rg >= 2) { if (dh == 0) att::pv_half<1, 0>(o2, vb0, pw[4], pw[5], pw[6], pw[7]); else att::pv_half<1, 2>(o2, vb0, pw[4], pw[5], pw[6], pw[7]); }
                char* ob = (char*)(MG + (m0 + rg * 32) * DM + DA + h * HD + dh * 64); char* sb = (char*)(SSG + (m0 + rg * 32) * 16 + h * 2 + dh);
                float sqv[16];
#pragma unroll
                for (int r = 0; r < 16; ++r) { const int rc = (r & 3) + 8 * (r >> 2);
                    const float v0 = bf_lo(uv[r]) * o2[0][r], v1 = bf_hi(uv[r]) * o2[1][r];
                    const unsigned w = att::cvtpk(v0, v1); const float r0 = bf_lo(w), r1 = bf_hi(w); sqv[r] = r0 * r0 + r1 * r1;
                    *(unsigned*)(ob + (size_t)(rc * DM) * 2 + olane) = w; }
                if (nu < NUNITS) GM_LOAD_U(nu);
                { const float tot = att::rowsum16(sqv, r32); const int rr = r32 >> 1;
                  if ((r32 & 1) == 0) *(float*)(sb + (size_t)(((rr & 3) + 8 * (rr >> 2)) * 16) * 4 + (unsigned)(4 * hi * 16) * 4u) = tot; }
                __syncthreads();
            }
#undef GM_LOAD_Y
#undef GM_LOAD_U
        }
        __syncthreads();
        if (vcu < TOTAL) {
            int L = vcu, pass = 0, par = 0;
#define mkref(LL, ps) mk_block_ref((LL) % TOTAL, (ps), Qb, Kb, Vb, MG, NB, SSA)
            att::BlockRef cur = mkref(L, 0);
            att::Seam S;
            att::prime(cur, shm, S, tid);
            for (;;) {
                const bool more_pass = pass == 0, more_item = L + G < TOTAL * ATT_DUP, last = !more_pass && !more_item;
                int passn = pass + 1, Ln = L;
                if (!more_pass) { passn = 0; Ln = more_item ? L + G : L; }
                const att::BlockRef nxt = last ? cur : mkref(Ln, passn);
                att::block(cur, nxt, shm, S, par, tid);
                if (last) break;
                cur = nxt; pass = passn; L = Ln; par ^= 1;
            }
        }
    }
    SEAM();

    REP(6) {
        PHASE_ARGS; const float* x = INP(0); bf16* XN = (bf16*)(ws + WS_XN); bf16* WOt = (bf16*)(ws + WS_WO); bf16* X1B = (bf16*)(ws + WS_X1B); const float* SSA = (const float*)(ws + WS_SSA); const float* SSG = (const float*)(ws + WS_SSG);
        pg8::Gemm g{XN, WOt, M, DM, DM}; pg8::StaticOrder S; S.init(M, DM, G, bx);
        LAS f32x2* tab = (LAS f32x2*)(ldsl + 131072 + 256);
        { pg8::Unit uu; int nun = 0; while (nun < 7 && S.next(nun, uu)) ++nun;
          for (int idx = tid; idx < nun * 256; idx += 512) { S.next(idx >> 8, uu); const size_t row = (size_t)uu.pm * 256 + (idx & 255);
              const f32x4 a0 = *(const f32x4*)(SSA + row * 8), a1 = *(const f32x4*)(SSA + row * 8 + 4);
              const f32x4 q0 = *(const f32x4*)(SSG + row * 16), q1 = *(const f32x4*)(SSG + row * 16 + 4), q2 = *(const f32x4*)(SSG + row * 16 + 8), q3 = *(const f32x4*)(SSG + row * 16 + 12);
              const float sa = ((a0[0] + a0[1]) + (a0[2] + a0[3])) + ((a1[0] + a1[1]) + (a1[2] + a1[3]));
              const float sg = (((q0[0] + q0[1]) + (q0[2] + q0[3])) + ((q1[0] + q1[1]) + (q1[2] + q1[3]))) + (((q2[0] + q2[1]) + (q2[2] + q2[3])) + ((q3[0] + q3[1]) + (q3[2] + q3[3])));
              const float rsa = 1.0f / sqrtf(sa * (1.f / 1024.f) + EPS), rsg = 1.0f / sqrtf(sg * (1.f / 1024.f) + EPS);
              tab[idx] = (f32x2){rsa / rsg, rsg}; }
          __syncthreads(); }
        pg8::EpiRes E{x, X1B, tab};
        pg8::gemm_phase<pg8::EpiRes, pg8::StaticOrder, true, true>(ldsl, g, S, E, tid);
    }
    SEAM();

    REP(7) {
        PHASE_ARGS; bf16* X1B = (bf16*)(ws + WS_X1B); bf16* WF1t = (bf16*)(ws + WS_WF1); bf16* HID = (bf16*)(ws + WS_HID);
        pg8::Gemm g{X1B, WF1t, M, DFF, DM}; pg8::StaticOrder S; S.init(M, DFF, G, bx);
        pg8::EpiRelu2 E{HID, DFF};
        pg8::gemm_phase<pg8::EpiRelu2, pg8::StaticOrder, true, true>(ldsl, g, S, E, tid);
    }
    SEAM();

    REP(8) {
        PHASE_ARGS; bf16* HID = (bf16*)(ws + WS_HID); bf16* WF2t = (bf16*)(ws + WS_WF2); bf16* Y16 = (bf16*)(ws + WS_Y16);
        pg8::Gemm g{HID, WF2t, M, DM, DFF}; pg8::StaticOrder S; S.init(M, DM, G, bx);
        pg8::EpiY16 E{Y16};
        pg8::gemm_phase<pg8::EpiY16, pg8::StaticOrder, true, true>(ldsl, g, S, E, tid);
    }
    SEAM();

    REP(9) {
        PHASE_ARGS; const float* g_fin = INP(14); const bf16* X1B = (const bf16*)(ws + WS_X1B); const bf16* Y16 = (const bf16*)(ws + WS_Y16); float* OUT = A_->out;
        for (int m = gw; m < M; m += NGW) {
            const v2u* xr = (const v2u*)(X1B + (size_t)m * DM) + lane; const v2u* yr = (const v2u*)(Y16 + (size_t)m * DM) + lane;
            f32x4 v[8], y[8]; float s = 0.f;
#pragma unroll
            for (int j = 0; j < 8; ++j) { const v2u w = xr[64 * j], wy = yr[64 * j]; y[j] = (f32x4){bf_lo(wy.x), bf_hi(wy.x), bf_lo(wy.y), bf_hi(wy.y)}; v[j] = (f32x4){bf_lo(w.x), bf_hi(w.x), bf_lo(w.y), bf_hi(w.y)}; s += (v[j][0] * v[j][0] + v[j][1] * v[j][1]) + (v[j][2] * v[j][2] + v[j][3] * v[j][3]); }
            const float r1 = 1.0f / (wave_sum(s) * (1.f / DM) + EPS);
            float s2 = 0.f;
#pragma unroll
            for (int j = 0; j < 8; ++j) { v[j] = v[j] + y[j] * r1; s2 += (v[j][0] * v[j][0] + v[j][1] * v[j][1]) + (v[j][2] * v[j][2] + v[j][3] * v[j][3]); }
            const float r2 = 1.0f / sqrtf(wave_sum(s2) * (1.f / DM) + EPS);
            f32x4* orow = (f32x4*)(OUT + (size_t)m * DM) + lane;
#pragma unroll
            for (int j = 0; j < 8; ++j) orow[64 * j] = v[j] * r2 * *((const f32x4*)g_fin + lane + 64 * j);
        }
    }
}

extern "C" void kernel_launch(void* const* d_in, const int* in_sizes, int n_in, void* d_out, int out_size, void* d_ws, size_t ws_size, hipStream_t stream) {
    static int grid = 0;
    if (grid == 0) {
        if (n_in != 15 || in_sizes[0] != M * DM || out_size != M * DM || ws_size < WS_END) { fprintf(stderr, "kernel_launch: shape/workspace mismatch (n_in %d, in0 %d, out %d, ws %zu < %zu)\n", n_in, n_in > 0 ? in_sizes[0] : -1, out_size, ws_size, (size_t)WS_END); grid = -1; return; }
        int dev = 0, cus = 0, per_cu = 0;
        hipGetDevice(&dev); hipDeviceGetAttribute(&cus, hipDeviceAttributeMultiprocessorCount, dev);
        if (hipFuncSetAttribute((const void*)mk_fwd, hipFuncAttributeMaxDynamicSharedMemorySize, LDS_BYTES) != hipSuccess) { fprintf(stderr, "kernel_launch: hipFuncSetAttribute failed\n"); grid = -1; return; }
        if (hipOccupancyMaxActiveBlocksPerMultiprocessor(&per_cu, (const void*)mk_fwd, NWAVES * 64, LDS_BYTES) != hipSuccess || per_cu < 1) { fprintf(stderr, "kernel_launch: occupancy query says %d\n", per_cu); per_cu = 1; }
        (void)hipGetLastError();
        grid = cus * per_cu;
    }
    if (grid < 0) return;
    if (hipMemsetAsync(d_ws, 0, 16384, stream) != hipSuccess) { fprintf(stderr, "kernel_launch: hipMemsetAsync of the barrier words failed\n"); return; }
    Args a{};
    for (int i = 0; i < 15; ++i) a.in[i] = (const float*)d_in[i];
    a.out = (float*)d_out; a.ws = (unsigned char*)d_ws;
    void* kargs[] = {&a};
    hipError_t e = hipLaunchCooperativeKernel((const void*)mk_fwd, dim3(grid), dim3(NWAVES * 64), kargs, LDS_BYTES, stream);
    if (e != hipSuccess) fprintf(stderr, "cooperative launch failed: %s (grid %d)\n", hipGetErrorString(e), grid);
}
```

```cpp
#include <hip/hip_runtime.h>
#include <hip/hip_cooperative_groups.h>
#include <hip/hip_bf16.h>
#include <cstdio>
#include <cstdint>
#include <cmath>
namespace pg8 {
#define PG8_LAS __attribute__((address_space(3)))
typedef unsigned short bf16_t;
typedef short bf16x8 __attribute__((ext_vector_type(8)));
typedef float f32x4 __attribute__((ext_vector_type(4)));
typedef unsigned u32x4 __attribute__((ext_vector_type(4)));
constexpr int BM = 256, BK = 64, HALF = 128, HTB = HALF * BK * 2  , STAGE_BYTES = 8 * HTB, NXCD = 8;

__host__ __device__ __forceinline__ int lds_byte(int r, int c) { const int st = (r >> 4) * 2 + (c >> 5), rr = r & 15, cc = c & 31, ob = rr * 64 + cc * 2; return st * 1024 + (ob ^ (((ob >> 9) & 1) << 5)); }
__host__ __device__ __forceinline__ void stage_rc(int b, int& R, int& C) { const int st = b / 1024, sb = b % 1024, swz = sb ^ (((sb >> 9) & 1) << 5); R = (st >> 1) * 16 + swz / 64; C = (st & 1) * 32 + (swz % 64) / 2; }
__host__ __device__ __forceinline__ int perm32(int rho) { const int n = rho >> 4, i = rho & 15; return 8 * (i >> 2) + 4 * n + (i & 3); }

struct Unit { int pm, pn; };
struct Gemm { const bf16_t* A; const bf16_t* Bt; int M, N, K; };

struct StaticOrder {
    int nM, nN, nwg, G, c, WGM;
    __host__ __device__ void init(int M, int N, int G_, int c_, int wgm) { nM = M / BM; nN = N / BM; nwg = nM * nN; G = G_; c = c_; WGM = wgm; }
    __host__ __device__ bool next(int i, Unit& u) const {
        const long L = (long)i * G + c; if (L >= nwg) return false;
        int wgid = (int)L; { const int q = nwg / NXCD, r = nwg % NXCD, xcd = wgid % NXCD, off = wgid / NXCD; wgid = (xcd < r ? xcd * (q + 1) : r * (q + 1) + (xcd - r) * q) + off; }
        const int nig = WGM * nN, gid = wgid / nig, fm = gid * WGM, gsz = (nM - fm) < WGM ? (nM - fm) : WGM;
        u.pm = fm + ((wgid % nig) % gsz); u.pn = (wgid % nig) / gsz; return true;
    }
    __device__ __forceinline__ void a_ready(const Unit&) const {}
    __device__ __forceinline__ void done(const Unit&) const {}
};

__device__ __forceinline__ unsigned cvt_pk_bf16(float lo, float hi) { unsigned r; asm volatile("v_cvt_pk_bf16_f32 %0, %1, %2" : "=v"(r) : "v"(lo), "v"(hi)); return r; }
typedef float f32x2 __attribute__((ext_vector_type(2)));
typedef unsigned u32x2 __attribute__((ext_vector_type(2)));
__device__ __forceinline__ float gelu_tanh(float v) {
    const float t = v * (1.0f + 0.044715f * v * v);
    const float e = __builtin_amdgcn_exp2f(-2.302208198f * t);
    return v * __builtin_amdgcn_rcpf(1.0f + e);
}
constexpr int SEQ_ = 4096, NH_ = 8;
struct EpiIn {
    static constexpr bool PERM = true, AFTER_DRAIN = false, MIDHOOK = false;
    bf16_t* Q; bf16_t* Kk; bf16_t* V; bf16_t* U; bf16_t* Y; float* lnst;
    __device__ __forceinline__ void operator()(const f32x4 (&acc)[2][2][4][2], const Unit& u, int wr, int wc, int fr, int fq) const {
        const int grp = u.pn >> 2, sub = u.pn & 3;
        const int row0 = u.pm * BM + wr * 64 + fr;
        if (grp < 3) {
            bf16_t* base = Q + (size_t)grp * (size_t)(16u << 20);
#pragma unroll
            for (int ai = 0; ai < 2; ++ai)
#pragma unroll
                for (int m = 0; m < 4; ++m) { const int row = row0 + ai * HALF + m * 16; const int b = row / SEQ_, s = row % SEQ_;
#pragma unroll
                    for (int bj = 0; bj < 2; ++bj) { const int head = sub * 2 + bj;
                        bf16_t* p = base + ((size_t)(b * NH_ + head) * SEQ_ + s) * 128 + wc * 32 + 8 * fq;
                        const f32x4 v0 = acc[ai][bj][m][0], v1 = acc[ai][bj][m][1];
                        u32x4 w; w.x = cvt_pk_bf16(v0[0], v0[1]); w.y = cvt_pk_bf16(v0[2], v0[3]); w.z = cvt_pk_bf16(v1[0], v1[1]); w.w = cvt_pk_bf16(v1[2], v1[3]);
                        *(u32x4*)p = w; } }
        } else {
            bf16_t* base = Q + (size_t)grp * (size_t)(16u << 20);
#pragma unroll
            for (int ai = 0; ai < 2; ++ai)
#pragma unroll
                for (int m = 0; m < 4; ++m) { const int row = row0 + ai * HALF + m * 16;
                    bf16_t* rowp = base + (size_t)row * 1024 + sub * 256 + wc * 32 + 8 * fq;
                    float s1 = 0.f, s2 = 0.f;
#pragma unroll
                    for (int bj = 0; bj < 2; ++bj) { const f32x4 v0 = acc[ai][bj][m][0], v1 = acc[ai][bj][m][1];
                        u32x4 w; w.x = cvt_pk_bf16(gelu_tanh(v0[0]), gelu_tanh(v0[1])); w.y = cvt_pk_bf16(gelu_tanh(v0[2]), gelu_tanh(v0[3]));
                        w.z = cvt_pk_bf16(gelu_tanh(v1[0]), gelu_tanh(v1[1])); w.w = cvt_pk_bf16(gelu_tanh(v1[2]), gelu_tanh(v1[3]));
                        *(u32x4*)(rowp + bj * HALF) = w;
                        if (grp == 4) {
#pragma unroll
                            for (int e = 0; e < 4; ++e) { const float lo = __uint_as_float(w[e] << 16), hi = __uint_as_float(w[e] & 0xffff0000u); s1 += lo + hi; s2 += lo * lo + hi * hi; } } }
                    if (grp == 4) { s1 += __shfl_xor(s1, 16); s1 += __shfl_xor(s1, 32); s2 += __shfl_xor(s2, 16); s2 += __shfl_xor(s2, 32);
                        if (fq == 0) *(f32x2*)(lnst + ((size_t)row * 16 + sub * 4 + wc) * 2) = (f32x2){s1, s2}; } }
        }
    }
};
struct EpiRes {
    static constexpr bool PERM = true, AFTER_DRAIN = false, MIDHOOK = true;
    const float* X; bf16_t* X1b; const PG8_LAS f32x2* tab;
    __device__ __forceinline__ void mid(f32x4 (&acc)[2][2][4][2], int ui, int wr, int fr) const {
#pragma unroll
        for (int ai = 0; ai < 2; ++ai)
#pragma unroll
            for (int m = 0; m < 4; ++m) { const float ratio = tab[ui * BM + ai * HALF + wr * 64 + m * 16 + fr].x;
#pragma unroll
                for (int bj = 0; bj < 2; ++bj)
#pragma unroll
                    for (int n = 0; n < 2; ++n) acc[ai][bj][m][n] = acc[ai][bj][m][n] * ratio; }
    }
    __device__ __forceinline__ void operator()(const f32x4 (&acc)[2][2][4][2], const Unit& u, int ui, int wr, int wc, int fr, int fq) const {
        const int row0 = u.pm * BM + wr * 64 + fr, col0 = u.pn * BM + wc * 32 + 8 * fq;
#pragma unroll
        for (int ai = 0; ai < 2; ++ai)
#pragma unroll
            for (int m = 0; m < 4; ++m) { const size_t off = (size_t)(row0 + ai * HALF + m * 16) * 2048 + col0; const float rsg = tab[ui * BM + ai * HALF + wr * 64 + m * 16 + fr].y;
#pragma unroll
                for (int bj = 0; bj < 2; ++bj) { const f32x4 o0 = *(const f32x4*)(X + off + bj * HALF) + acc[ai][bj][m][0] * rsg, o1 = *(const f32x4*)(X + off + bj * HALF + 4) + acc[ai][bj][m][1] * rsg;
                    u32x4 w; w.x = cvt_pk_bf16(o0[0], o0[1]); w.y = cvt_pk_bf16(o0[2], o0[3]); w.z = cvt_pk_bf16(o1[0], o1[1]); w.w = cvt_pk_bf16(o1[2], o1[3]);
                    *(u32x4*)(X1b + off + bj * HALF) = w; } }
    }
};
struct EpiRelu2 {
    static constexpr bool PERM = true, AFTER_DRAIN = false, MIDHOOK = false;
    bf16_t* O; int ldc;
    __device__ __forceinline__ void operator()(const f32x4 (&acc)[2][2][4][2], const Unit& u, int wr, int wc, int fr, int fq) const {
        const int row0 = u.pm * BM + wr * 64 + fr, col0 = u.pn * BM + wc * 32 + 8 * fq;
#pragma unroll
        for (int ai = 0; ai < 2; ++ai)
#pragma unroll
            for (int m = 0; m < 4; ++m) { bf16_t* rowp = O + (size_t)(row0 + ai * HALF + m * 16) * ldc + col0;
#pragma unroll
                for (int bj = 0; bj < 2; ++bj) { f32x4 v0 = acc[ai][bj][m][0], v1 = acc[ai][bj][m][1];
#pragma unroll
                    for (int e = 0; e < 4; ++e) { const float a = fmaxf(v0[e], 0.f), b = fmaxf(v1[e], 0.f); v0[e] = a * a; v1[e] = b * b; }
                    u32x4 w; w.x = cvt_pk_bf16(v0[0], v0[1]); w.y = cvt_pk_bf16(v0[2], v0[3]); w.z = cvt_pk_bf16(v1[0], v1[1]); w.w = cvt_pk_bf16(v1[2], v1[3]);
                    *(u32x4*)(rowp + bj * HALF) = w; } }
    }
};
struct EpiY16 {
    static constexpr bool PERM = true, AFTER_DRAIN = false, MIDHOOK = false;
    bf16_t* Yo;
    __device__ __forceinline__ void operator()(const f32x4 (&acc)[2][2][4][2], const Unit& u, int wr, int wc, int fr, int fq) const {
        const int row0 = u.pm * BM + wr * 64 + fr, col0 = u.pn * BM + wc * 32 + 8 * fq;
#pragma unroll
        for (int ai = 0; ai < 2; ++ai)
#pragma unroll
            for (int m = 0; m < 4; ++m) { bf16_t* rowp = Yo + (size_t)(row0 + ai * HALF + m * 16) * 2048 + col0;
#pragma unroll
                for (int bj = 0; bj < 2; ++bj) { const f32x4 v0 = acc[ai][bj][m][0], v1 = acc[ai][bj][m][1];
                    u32x4 w; w.x = cvt_pk_bf16(v0[0], v0[1]); w.y = cvt_pk_bf16(v0[2], v0[3]); w.z = cvt_pk_bf16(v1[0], v1[1]); w.w = cvt_pk_bf16(v1[2], v1[3]);
                    *(u32x4*)(rowp + bj * HALF) = w; } }
    }
};

template <class Epi, class Sched, bool ALIGN_EPI = false, bool SP2 = false>
__device__ __forceinline__ void gemm_phase(PG8_LAS unsigned char* lds, const Gemm g, const Sched& S, const Epi& E, const int tid) {
    const int wid = __builtin_amdgcn_readfirstlane(tid >> 6), lane = tid & 63, wr = wid >> 2, wc = wid & 3, fr = lane & 15, fq = lane >> 4;
    const int K = g.K, nt = K / BK;
    unsigned voffA[2], voffB[2];
#pragma unroll
    for (int i = 0; i < 2; ++i) { int R, C; stage_rc(tid * 16 + i * 8192, R, C); const int Rb = Epi::PERM ? ((R & ~31) + perm32(R & 31)) : R;
        voffA[i] = (unsigned)(R * K + C) * 2u; voffB[i] = (unsigned)(Rb * K + C) * 2u; }
    const size_t kstep = (size_t)(BK * 2);
    const size_t hstep = (size_t)HALF * K * 2;
    const size_t tstep = 2 * hstep;
    const unsigned ldsw = (unsigned)wid * 1024u;
    const int aoff = lds_byte(wr * 64 + fr, fq * 8), boff = lds_byte(wc * 32 + fr, fq * 8);
#define PG8_SA(b, h) (((b) * 2 + (h)) * HTB)
#define PG8_SB(b, h) ((4 + (b) * 2 + (h)) * HTB)
#define PG8_STAGE(bufoff, gbase, voff) do { _Pragma("unroll") for (int _i = 0; _i < 2; ++_i) \
        __builtin_amdgcn_global_load_lds((const unsigned*)((const char*)(gbase) + (voff)[_i]), (PG8_LAS unsigned*)(lds + (bufoff) + ldsw + _i * 8192), 16, 0, 0); } while (0)
#define PG8_LDA(dst, b, h) do { _Pragma("unroll") for (int m = 0; m < 4; ++m) _Pragma("unroll") for (int k = 0; k < 2; ++k) dst[m][k] = *(const PG8_LAS bf16x8*)(lds + PG8_SA(b, h) + aoff + m * 2048 + k * 1024); } while (0)
#define PG8_LDB(dst, b, h) do { _Pragma("unroll") for (int n = 0; n < 2; ++n) _Pragma("unroll") for (int k = 0; k < 2; ++k) dst[n][k] = *(const PG8_LAS bf16x8*)(lds + PG8_SB(b, h) + boff + n * 2048 + k * 1024); } while (0)
#define PG8_MMA(ai, bj, At, Bt) do { __builtin_amdgcn_s_setprio(1); _Pragma("unroll") for (int m = 0; m < 4; ++m) _Pragma("unroll") for (int n = 0; n < 2; ++n) _Pragma("unroll") for (int k = 0; k < 2; ++k) \
        acc[ai][bj][m][n] = __builtin_amdgcn_mfma_f32_16x16x32_bf16(Bt[n][k], At[m][k], acc[ai][bj][m][n], 0, 0, 0); __builtin_amdgcn_s_setprio(0); } while (0)
#define PG8_WAIT_V(n) asm volatile("s_waitcnt vmcnt(" #n ")" ::: "memory")
#define PG8_WAIT_L(n) asm volatile("s_waitcnt lgkmcnt(" #n ")" ::: "memory")
#define PG8_BAR __builtin_amdgcn_s_barrier()
#define PG8_SCHED __builtin_amdgcn_sched_barrier(0)
    Unit cur, nxt; int ui = 0;
    if (!S.next(0, cur)) return;
    f32x4 acc[2][2][4][2];
#pragma unroll
    for (int a = 0; a < 2; ++a)
#pragma unroll
        for (int b = 0; b < 2; ++b)
#pragma unroll
            for (int m = 0; m < 4; ++m)
#pragma unroll
                for (int n = 0; n < 2; ++n) acc[a][b][m][n] = (f32x4){0.f, 0.f, 0.f, 0.f};
    bf16x8 At[4][2], B0[2][2], B1[2][2];
    const char* cA = (const char*)g.A + (size_t)cur.pm * tstep; const char* cB = (const char*)g.Bt + (size_t)cur.pn * tstep;
    S.a_ready(cur);
    if constexpr (SP2) {
        PG8_STAGE(PG8_SB(0, 0), cB, voffB); PG8_STAGE(PG8_SB(0, 1), cB + hstep, voffB); PG8_STAGE(PG8_SA(0, 0), cA, voffA); PG8_STAGE(PG8_SA(0, 1), cA + hstep, voffA);
        if (wr == 1) PG8_BAR;
        PG8_WAIT_V(2); PG8_BAR;
        PG8_STAGE(PG8_SB(1, 0), cB + kstep, voffB); PG8_STAGE(PG8_SA(1, 0), cA + kstep, voffA); PG8_STAGE(PG8_SB(1, 1), cB + hstep + kstep, voffB);
        PG8_WAIT_V(6); PG8_BAR;
    } else {
        PG8_STAGE(PG8_SB(0, 0), cB, voffB); PG8_STAGE(PG8_SA(0, 0), cA, voffA); PG8_STAGE(PG8_SB(0, 1), cB + hstep, voffB); PG8_STAGE(PG8_SA(0, 1), cA + hstep, voffA);
        if (wr == 1) PG8_BAR;
        PG8_WAIT_V(4); PG8_BAR;
        PG8_STAGE(PG8_SB(1, 0), cB + kstep, voffB); PG8_STAGE(PG8_SA(1, 0), cA + kstep, voffA); PG8_STAGE(PG8_SB(1, 1), cB + hstep + kstep, voffB);
        PG8_WAIT_V(6); PG8_BAR;
    }
    for (;;) {
        const bool has_next = S.next(ui + 1, nxt);
        const char* nA = has_next ? (const char*)g.A + (size_t)nxt.pm * tstep : cA; const char* nB = has_next ? (const char*)g.Bt + (size_t)nxt.pn * tstep : cB;
        for (int t = 0; t < nt; t += 2) {
            if constexpr (Epi::MIDHOOK) { if (t == (nt >> 1)) E.mid(acc, ui, wr, fr); }
            const bool last = (t == nt - 2);
            const char* a1 = cA + (size_t)(t + 1) * kstep;
            const char* a2 = last ? nA : cA + (size_t)(t + 2) * kstep; const char* b2 = last ? nB : cB + (size_t)(t + 2) * kstep;
            const char* a3 = a2 + kstep; const char* b3 = b2 + kstep;
            if (last && has_next) S.a_ready(nxt);
            if constexpr (SP2) {
            PG8_LDB(B0, 0, 0); PG8_LDB(B1, 0, 1); PG8_SCHED; PG8_LDA(At, 0, 0); PG8_STAGE(PG8_SA(1, 1), a1 + hstep, voffA);
            PG8_WAIT_V(8); PG8_WAIT_L(0); PG8_BAR; PG8_MMA(0, 0, At, B0); PG8_MMA(0, 1, At, B1); PG8_BAR; PG8_SCHED;
            PG8_LDA(At, 0, 1); PG8_STAGE(PG8_SB(0, 0), b2, voffB); PG8_STAGE(PG8_SB(0, 1), b2 + hstep, voffB); PG8_STAGE(PG8_SA(0, 0), a2, voffA);
            PG8_WAIT_V(8); PG8_WAIT_L(0); PG8_BAR; PG8_MMA(1, 0, At, B0); PG8_MMA(1, 1, At, B1); PG8_BAR; PG8_SCHED;
            PG8_LDB(B0, 1, 0); PG8_LDB(B1, 1, 1); PG8_SCHED; PG8_LDA(At, 1, 0); PG8_STAGE(PG8_SA(0, 1), a2 + hstep, voffA);
            PG8_WAIT_V(8); PG8_WAIT_L(0); PG8_BAR; PG8_MMA(0, 0, At, B0); PG8_MMA(0, 1, At, B1); PG8_BAR; PG8_SCHED;
            PG8_LDA(At, 1, 1); PG8_STAGE(PG8_SB(1, 0), b3, voffB); PG8_STAGE(PG8_SB(1, 1), b3 + hstep, voffB); PG8_STAGE(PG8_SA(1, 0), a3, voffA);
            PG8_WAIT_V(8); PG8_WAIT_L(0); PG8_BAR; PG8_MMA(1, 0, At, B0); PG8_MMA(1, 1, At, B1); PG8_BAR; PG8_SCHED;
            } else {
            PG8_LDB(B0, 0, 0); PG8_SCHED; PG8_LDA(At, 0, 0); PG8_STAGE(PG8_SA(1, 1), a1 + hstep, voffA);
            PG8_WAIT_L(8); PG8_BAR; PG8_WAIT_L(0); PG8_MMA(0, 0, At, B0); PG8_BAR; PG8_SCHED;
            PG8_LDB(B1, 0, 1); PG8_STAGE(PG8_SB(0, 0), b2, voffB);
            PG8_BAR; PG8_WAIT_L(0); PG8_MMA(0, 1, At, B1); PG8_BAR;
            PG8_LDA(At, 0, 1); PG8_STAGE(PG8_SA(0, 0), a2, voffA);
            PG8_BAR; PG8_WAIT_L(0); PG8_MMA(1, 0, At, B0); PG8_BAR; PG8_SCHED;
            PG8_STAGE(PG8_SB(0, 1), b2 + hstep, voffB);
            PG8_WAIT_V(6); PG8_BAR; PG8_MMA(1, 1, At, B1); PG8_BAR;
            PG8_LDB(B0, 1, 0); PG8_SCHED; PG8_LDA(At, 1, 0); PG8_STAGE(PG8_SA(0, 1), a2 + hstep, voffA);
            PG8_WAIT_L(8); PG8_BAR; PG8_WAIT_L(0); PG8_MMA(0, 0, At, B0); PG8_BAR; PG8_SCHED;
            PG8_LDB(B1, 1, 1); PG8_STAGE(PG8_SB(1, 0), b3, voffB);
            PG8_BAR; PG8_WAIT_L(0); PG8_MMA(0, 1, At, B1); PG8_BAR;
            PG8_LDA(At, 1, 1); PG8_STAGE(PG8_SA(1, 0), a3, voffA);
            PG8_BAR; PG8_WAIT_L(0); PG8_MMA(1, 0, At, B0); PG8_BAR; PG8_SCHED;
            PG8_STAGE(PG8_SB(1, 1), b3 + hstep, voffB);
            PG8_WAIT_V(6); PG8_BAR; PG8_MMA(1, 1, At, B1); PG8_BAR;
            }
        }
        if constexpr (ALIGN_EPI) { if (wr == 0) PG8_BAR; }
        if constexpr (!Epi::AFTER_DRAIN) { if constexpr (Epi::MIDHOOK) E(acc, cur, ui, wr, wc, fr, fq); else E(acc, cur, wr, wc, fr, fq); S.done(cur); }
        if (!has_next) break;
#pragma unroll
        for (int a = 0; a < 2; ++a)
#pragma unroll
            for (int b = 0; b < 2; ++b)
#pragma unroll
                for (int m = 0; m < 4; ++m)
#pragma unroll
                    for (int n = 0; n < 2; ++n) acc[a][b][m][n] = (f32x4){0.f, 0.f, 0.f, 0.f};
        cur = nxt; cA = nA; cB = nB; ++ui;
        if constexpr (ALIGN_EPI) { if (wr == 1) PG8_BAR; }
    }
    PG8_WAIT_V(0);
    if constexpr (!ALIGN_EPI) { if (wr == 0) PG8_BAR; }
    PG8_BAR;
    if constexpr (Epi::AFTER_DRAIN) { E.fused(acc, cur, wr, wc, fr, fq, lds, wid, lane); S.done(cur); }
#undef PG8_SA
#undef PG8_SB
#undef PG8_STAGE
#undef PG8_LDA
#undef PG8_LDB
#undef PG8_MMA
#undef PG8_WAIT_V
#undef PG8_WAIT_L
#undef PG8_BAR
#undef PG8_SCHED
}
}
namespace att {
using bf16 = __hip_bfloat16;
typedef short bf16x8 __attribute__((ext_vector_type(8)));
typedef short s16x4 __attribute__((ext_vector_type(4)));
typedef float f32x16 __attribute__((ext_vector_type(16)));
typedef float f32x4 __attribute__((ext_vector_type(4)));
typedef unsigned u32x4 __attribute__((ext_vector_type(4)));
constexpr int D = 128, SEQ = 4096, OP = 2048;
constexpr float SCALE = 0.08838834764831845f, THR = 8.f;
constexpr int NW = 8, QBLK = 32, KVBLK = 64, QB = NW * QBLK;
constexpr int SHM_V = KVBLK * D * 2, SHM_K = KVBLK * D * 2;
constexpr int OFF_WS = 2 * SHM_V + 2 * SHM_K, OFF_BIAS = OFF_WS + NW * 64 * 4, BIAS_BYTES = SEQ * 4, LDS_BYTES = OFF_BIAS + 2 * BIAS_BYTES;

#define KSWZ(row, colB) ((row) * 256 + ((colB) ^ (((row) & 7) << 4)))
#define SBAR() __builtin_amdgcn_sched_barrier(0)
__device__ __forceinline__ int v_st(int k, int c) { const int kk = (k & ~0xC) | ((k & 4) << 1) | ((k & 8) >> 1); return ((kk >> 3) * 4 + (c >> 5)) * 512 + ((kk & 7) * 32 + (c & 31)) * 2; }
__device__ __forceinline__ int v_rd_base(int lane) { return ((lane & 3) << 3) | (((lane >> 2) & 3) << 6) | (((lane >> 4) & 1) << 5) | (((lane >> 5) & 1) << 8); }
constexpr int v_rd_off(int d0, int ks, int half) { return d0 * 512 + ks * 4096 + half * 2048; }
__device__ __forceinline__ int crow(int r, int hi) { return (r & 3) + 8 * (r >> 2) + 4 * hi; }
__device__ __forceinline__ unsigned cvtpk(float lo, float hi) { unsigned r; asm volatile("v_cvt_pk_bf16_f32 %0, %1, %2" : "=v"(r) : "v"(lo), "v"(hi)); return r; }
__device__ __forceinline__ bf16x8 load8(const bf16* p) { return *reinterpret_cast<const bf16x8*>(p); }
__device__ __forceinline__ bf16x8 ldg16(const char* sb, unsigned off) { return *reinterpret_cast<const bf16x8*>(sb + off); }
__device__ __forceinline__ void mask_tile(f32x16& p0, f32x16& p1, int dq, unsigned W) {
    const float NEG = -__builtin_inff();
#pragma unroll
    for (int r = 0; r < 16; ++r) {
        const int c = (r & 3) + 8 * (r >> 2);
        if ((unsigned)(dq - c) >= W) p0[r] = NEG;
        if ((unsigned)(dq - c - 32) >= W) p1[r] = NEG;
    }
}
__device__ __forceinline__ void partialSM(f32x16& p0, f32x16& p1, float& m_reg, float& mn, float& alpha) {
    float pmax = p0[0]; for (int r = 1; r < 16; ++r) pmax = fmaxf(pmax, p0[r]); for (int r = 0; r < 16; ++r) pmax = fmaxf(pmax, p1[r]);
    { auto rr = __builtin_amdgcn_permlane32_swap(__float_as_uint(pmax), __float_as_uint(pmax), false, false);
      pmax = fmaxf(__uint_as_float(rr[0]), __uint_as_float(rr[1])); }
    constexpr float C2 = 1.4426950408889634f * SCALE;
    if (__builtin_expect(__all((pmax - m_reg) * SCALE <= THR), 1)) { mn = m_reg; alpha = 1.f; }
    else { mn = fmaxf(m_reg, pmax); alpha = __builtin_amdgcn_exp2f((m_reg - mn) * C2); m_reg = mn; }
    const float mnL = -mn * C2;
    for (int r = 0; r < 16; ++r) p0[r] = fmaf(p0[r], C2, mnL); for (int r = 0; r < 16; ++r) p1[r] = fmaf(p1[r], C2, mnL);
    for (int r = 0; r < 16; ++r) p0[r] = __builtin_amdgcn_exp2f(p0[r]);
}
__device__ __forceinline__ void finishSM(f32x16& p0, f32x16& p1, float alpha, float& l_reg, bf16x8& pa0, bf16x8& pa1, bf16x8& pa2, bf16x8& pa3) {
    for (int r = 0; r < 16; ++r) p1[r] = __builtin_amdgcn_exp2f(p1[r]);
    float ps = 0; for (int r = 0; r < 16; ++r) ps += p0[r]; for (int r = 0; r < 16; ++r) ps += p1[r];
    { auto rr = __builtin_amdgcn_permlane32_swap(__float_as_uint(ps), __float_as_uint(ps), false, false);
      ps = __uint_as_float(rr[0]) + __uint_as_float(rr[1]); }
    l_reg = l_reg * alpha + ps;
#define PK4(P, B_, OUT) do { unsigned a0 = cvtpk(P[B_+0], P[B_+1]), a1 = cvtpk(P[B_+2], P[B_+3]);                          \
        unsigned b0 = cvtpk(P[B_+4], P[B_+5]), b1 = cvtpk(P[B_+6], P[B_+7]);                                             \
        auto r0 = __builtin_amdgcn_permlane32_swap(a0, b0, false, false); auto r1 = __builtin_amdgcn_permlane32_swap(a1, b1, false, false); \
        u32x4 w = {r0[0], r1[0], r0[1], r1[1]}; OUT = *reinterpret_cast<bf16x8*>(&w); } while (0)
    PK4(p0, 0, pa0); PK4(p0, 8, pa1); PK4(p1, 0, pa2); PK4(p1, 8, pa3);
#undef PK4
}
template <int KB>
__device__ __forceinline__ void qkt(f32x16& p0, f32x16& p1, const char* K_lds, int r32, int hi, const bf16x8* qr, const float* bp) {
#pragma unroll
    for (int g = 0; g < 4; ++g) { const f32x4 a = *(const f32x4*)(bp + 8 * g), b = *(const f32x4*)(bp + 32 + 8 * g);
        p0[4 * g] = a[0]; p0[4 * g + 1] = a[1]; p0[4 * g + 2] = a[2]; p0[4 * g + 3] = a[3];
        p1[4 * g] = b[0]; p1[4 * g + 1] = b[1]; p1[4 * g + 2] = b[2]; p1[4 * g + 3] = b[3]; }
    const char* kb[4];
#pragma unroll
    for (int dd = 0; dd < 4; ++dd) kb[dd] = K_lds + KB * SHM_K + KSWZ(r32, (dd * 16 + hi * 8) * 2);
#pragma unroll
    for (int d0 = 0; d0 < 8; ++d0) { const char* a = kb[d0 & 3] + (d0 >> 2) * 128;
        bf16x8 b0 = *reinterpret_cast<const bf16x8*>(a);
        bf16x8 b1 = *reinterpret_cast<const bf16x8*>(a + 32 * 256);
        p0 = __builtin_amdgcn_mfma_f32_32x32x16_bf16(b0, qr[d0], p0, 0, 0, 0);
        p1 = __builtin_amdgcn_mfma_f32_32x32x16_bf16(b1, qr[d0], p1, 0, 0, 0); }
}
#define TRRD(dst, off) asm volatile("ds_read_b64_tr_b16 %0, %1 offset:%2" : "=&v"(dst) : "v"(vb0), "i"(off) : "memory")
#define PV_D0(VB, d0, oo) do { s16x4 l0, l1, l2, l3, h0, h1, h2, h3; constexpr int b_ = (VB) * SHM_V + v_rd_off(d0, 0, 0);   \
        TRRD(l0, b_); TRRD(h0, b_ + 2048); TRRD(l1, b_ + 4096); TRRD(h1, b_ + 6144); TRRD(l2, b_ + 8192); TRRD(h2, b_ + 10240); TRRD(l3, b_ + 12288); TRRD(h3, b_ + 14336); \
        asm volatile("s_waitcnt lgkmcnt(0)" ::: "memory"); SBAR();                                                          \
        oo = __builtin_amdgcn_mfma_f32_32x32x16_bf16(pa0, (bf16x8){l0[0], l0[1], l0[2], l0[3], h0[0], h0[1], h0[2], h0[3]}, oo, 0, 0, 0);   \
        oo = __builtin_amdgcn_mfma_f32_32x32x16_bf16(pa1, (bf16x8){l1[0], l1[1], l1[2], l1[3], h1[0], h1[1], h1[2], h1[3]}, oo, 0, 0, 0);   \
        oo = __builtin_amdgcn_mfma_f32_32x32x16_bf16(pa2, (bf16x8){l2[0], l2[1], l2[2], l2[3], h2[0], h2[1], h2[2], h2[3]}, oo, 0, 0, 0);   \
        oo = __builtin_amdgcn_mfma_f32_32x32x16_bf16(pa3, (bf16x8){l3[0], l3[1], l3[2], l3[3], h3[0], h3[1], h3[2], h3[3]}, oo, 0, 0, 0); } while (0)
template <int VB>
__device__ __forceinline__ void pv_tile(f32x16* o, int vb0, bf16x8 pa0, bf16x8 pa1, bf16x8 pa2, bf16x8 pa3) {
    PV_D0(VB, 0, o[0]); PV_D0(VB, 1, o[1]); PV_D0(VB, 2, o[2]); PV_D0(VB, 3, o[3]);
}
template <int VB, int DA>
__device__ __forceinline__ void pv_half(f32x16* o2, int vb0, bf16x8 pa0, bf16x8 pa1, bf16x8 pa2, bf16x8 pa3) {
    PV_D0(VB, DA, o2[0]); PV_D0(VB, DA + 1, o2[1]);
}

__device__ __forceinline__ float rowsum16(const float (&sq)[16], int r32) {
    const bool b4 = r32 & 16, b3 = r32 & 8, b2 = r32 & 4, b1 = r32 & 2;
    float t[8], u[4], v[2];
#pragma unroll
    for (int j = 0; j < 8; ++j) { const float mine = b4 ? sq[8 + j] : sq[j], oth = b4 ? sq[j] : sq[8 + j]; t[j] = mine + __shfl_xor(oth, 16); }
#pragma unroll
    for (int j = 0; j < 4; ++j) { const float mine = b3 ? t[4 + j] : t[j], oth = b3 ? t[j] : t[4 + j]; u[j] = mine + __shfl_xor(oth, 8); }
#pragma unroll
    for (int j = 0; j < 2; ++j) { const float mine = b2 ? u[2 + j] : u[j], oth = b2 ? u[j] : u[2 + j]; v[j] = mine + __shfl_xor(oth, 4); }
    const float mine = b1 ? v[1] : v[0], oth = b1 ? v[0] : v[1]; float w = mine + __shfl_xor(oth, 2);
    return w + __shfl_xor(w, 1);
}
struct BlockRef { const bf16* Q; const bf16* K; const bf16* V; bf16* O; const float* NB; float* SS; int P0; };
struct Seam { bf16x8 qr[8]; bf16x8 st0, st1; };
#define VMW() asm volatile("s_waitcnt vmcnt(0)" ::: "memory")
#define VMWN(n) asm volatile("s_waitcnt vmcnt(%0)" :: "i"(n) : "memory")
#define SLOAD2(p, k0) do { const char* b_ = (const char*)(p) + (size_t)(k0) * (D * 2); S.st0 = ldg16(b_, voff); S.st1 = ldg16(b_ + 32 * D * 2, voff); } while (0)
#define SWRITE_K(bf) do { *(bf16x8*)(K_lds + (bf) * SHM_K + kws) = S.st0; *(bf16x8*)(K_lds + (bf) * SHM_K + kws + 32 * 256) = S.st1; } while (0)
#define SWRITE_V(bf) do { *(bf16x8*)(V_lds + (bf) * SHM_V + vst0) = S.st0; *(bf16x8*)(V_lds + (bf) * SHM_V + vst1) = S.st1; } while (0)
__device__ __forceinline__ void bias_to_lds(const float* NB, char* lds, int reg, const int tid) {
    const f32x4 a = *(const f32x4*)(NB + tid * 4), b = *(const f32x4*)(NB + 2048 + tid * 4);
    float* dst = (float*)(lds + OFF_BIAS + reg * BIAS_BYTES);
    *(f32x4*)(dst + tid * 4) = a; *(f32x4*)(dst + 2048 + tid * 4) = b;
}
__device__ __forceinline__ void prime(const BlockRef& cur, char* lds, Seam& S, const int tid) {
    const int wid = __builtin_amdgcn_readfirstlane(tid >> 6), lane = tid & 63, r32 = lane & 31, hi = lane >> 5;
    const int sr = tid >> 4, sc = (tid & 15) * 8, kws = KSWZ(sr, sc * 2); char* K_lds = lds + 2 * SHM_V; const unsigned voff = (unsigned)(sr * D + sc) * 2u;
#pragma unroll
    for (int d0 = 0; d0 < 8; ++d0) S.qr[d0] = load8(cur.Q + (size_t)(wid * QBLK + r32) * D + d0 * 16 + hi * 8);
    const int kb0 = ((cur.P0 + QB - 1) / KVBLK) * KVBLK;
    SLOAD2(cur.K, kb0);
    bias_to_lds(cur.NB, lds, 0, tid);
    VMW(); SWRITE_K(0); SBAR(); SLOAD2(cur.V, kb0);
    __syncthreads();
}
__device__ __forceinline__ void block(const BlockRef& cur, const BlockRef& nxt, char* lds, Seam& S, int par, const int tid) {
    const int wid = __builtin_amdgcn_readfirstlane(tid >> 6), lane = tid & 63, r32 = lane & 31, hi = lane >> 5;
    constexpr int W = SEQ;
    const int NT = (cur.P0 + QB - 1) / KVBLK + 1;
    const int qlo = cur.P0 + wid * QBLK, qm = qlo + r32 - 4 * hi;
    char* V_lds = lds; char* K_lds = lds + 2 * SHM_V;
    float* ws = (float*)(lds + OFF_WS) + wid * 64; float* li_l = ws, * al_l = ws + 32;
    const float* bl = (const float*)(lds + OFF_BIAS + par * BIAS_BYTES) + 4 * hi;
    float m_reg = -1e30f, l_reg = 0; f32x16 o[4] = {};
    const int sr = tid >> 4, sc = (tid & 15) * 8, vst0 = v_st(sr, sc), vst1 = v_st(32 + sr, sc), kws = KSWZ(sr, sc * 2); const unsigned voff = (unsigned)(sr * D + sc) * 2u;
    const int vb0 = (int)(uintptr_t)V_lds + v_rd_base(lane);
    const bf16* Kh = cur.K; const bf16* Vh = cur.V;
#define RESC(a) do { if (__any((a) < 1.f)) { if (hi == 0) al_l[r32] = (a); asm volatile("s_waitcnt lgkmcnt(0)" ::: "memory");              \
                     for (int d_ = 0; d_ < 4; ++d_) for (int r = 0; r < 16; ++r) o[d_][r] *= al_l[crow(r, hi)]; } } while (0)
#define KBASE(t) ((NT - 1 - (t)) * KVBLK)
#define MASKT(P0_, P1_, t) do { const int kb_ = KBASE(t); if (kb_ + KVBLK - 1 > qlo) mask_tile(P0_, P1_, qm - kb_, (unsigned)W); } while (0)
    f32x16 pA0, pA1, pB0, pB1; float mnA, mnB, alA, alB; bf16x8 pa0, pa1, pa2, pa3;
    VMW(); SWRITE_V(0); SBAR();
    SLOAD2(Kh, KBASE(1));
    SBAR(); qkt<0>(pA0, pA1, K_lds, r32, hi, S.qr, bl + KBASE(0));
    VMW(); SWRITE_K(1); SBAR(); SLOAD2(Vh, KBASE(1));
    MASKT(pA0, pA1, 0); partialSM(pA0, pA1, m_reg, mnA, alA);
    VMW(); SWRITE_V(1); SBAR(); if (NT > 2) SLOAD2(Kh, KBASE(2));
    __syncthreads();
#define HALF_STEP(PX0, PX1, mnX, alX, PY0, PY1, alY, t, KB, VB, SB) do {                                                      \
        SBAR(); qkt<KB>(PX0, PX1, K_lds, r32, hi, S.qr, bl + KBASE(t));                                                      \
        finishSM(PY0, PY1, alY, l_reg, pa0, pa1, pa2, pa3); SBAR();                                                           \
        if ((t) + 1 < NT) { VMW(); SWRITE_K(SB); SBAR(); SLOAD2(Vh, KBASE((t) + 1)); SBAR(); }                                \
        pv_tile<VB>(o, vb0, pa0, pa1, pa2, pa3); MASKT(PX0, PX1, (t)); partialSM(PX0, PX1, m_reg, mnX, alX);                  \
        __syncthreads();                                                                                                      \
        if ((t) + 1 < NT) { VMW(); SWRITE_V(SB); SBAR(); if ((t) + 2 < NT) SLOAD2(Kh, KBASE((t) + 2)); }                      \
        RESC(alX); __syncthreads(); } while (0)
    for (int t = 1; t + 1 < NT; t += 2) {
        HALF_STEP(pB0, pB1, mnB, alB, pA0, pA1, alA, t, 1, 0, 0);
        HALF_STEP(pA0, pA1, mnA, alA, pB0, pB1, alB, t + 1, 0, 1, 1);
    }
    SBAR(); qkt<1>(pB0, pB1, K_lds, r32, hi, S.qr, bl + KBASE(NT - 1)); SBAR();
    const int kbn = ((nxt.P0 + QB - 1) / KVBLK) * KVBLK;
    SLOAD2(nxt.K, kbn); SBAR();
#pragma unroll
    for (int d0 = 0; d0 < 8; ++d0) S.qr[d0] = load8(nxt.Q + (size_t)(wid * QBLK + r32) * D + d0 * 16 + hi * 8);
    SBAR();
    finishSM(pA0, pA1, alA, l_reg, pa0, pa1, pa2, pa3); SBAR();
    pv_tile<0>(o, vb0, pa0, pa1, pa2, pa3);
    MASKT(pB0, pB1, NT - 1); partialSM(pB0, pB1, m_reg, mnB, alB); __syncthreads(); RESC(alB);
    finishSM(pB0, pB1, alB, l_reg, pa0, pa1, pa2, pa3); SBAR(); pv_tile<1>(o, vb0, pa0, pa1, pa2, pa3);
    SBAR(); VMWN(8); SWRITE_K(0); SBAR(); SLOAD2(nxt.V, kbn); SBAR();
    if (hi == 0) li_l[r32] = l_reg; asm volatile("s_waitcnt lgkmcnt(0)" ::: "memory");
    float rli[16];
#pragma unroll
    for (int r = 0; r < 16; ++r) rli[r] = __builtin_amdgcn_rcpf(li_l[crow(r, hi)]);
    char* Owb = (char*)(cur.O + (size_t)(wid * QBLK) * OP); char* ssb = (char*)(cur.SS + (size_t)(wid * QBLK) * 8);
    const unsigned olane = (unsigned)((4 * hi) * OP + r32) * 2u, slane = (unsigned)(4 * hi * 8) * 4u;
#pragma unroll
    for (int r = 0; r < 16; ++r) { const int rc = (r & 3) + 8 * (r >> 2); float sq = 0.f;
#pragma unroll
        for (int d0 = 0; d0 < 4; ++d0) { const float v = o[d0][r] * rli[r];
            const float vn = __shfl_xor(v, 1); const unsigned w = cvtpk(v, vn); const float vr = __uint_as_float(w << 16); sq += vr * vr;
            if ((r32 & 1) == 0) *(unsigned*)(Owb + (size_t)(rc * OP + d0 * 32) * 2 + olane) = w; }
        sq += __shfl_xor(sq, 1); sq += __shfl_xor(sq, 2); sq += __shfl_xor(sq, 4); sq += __shfl_xor(sq, 8); sq += __shfl_xor(sq, 16);
        if (r32 == 0) *(float*)(ssb + (size_t)(rc * 8) * 4 + slane) = sq;
        asm volatile("" ::: "memory"); }
    bias_to_lds(nxt.NB, lds, par ^ 1, tid);
    __syncthreads();
#undef RESC
#undef KBASE
#undef MASKT
#undef HALF_STEP
}
}
namespace cg = cooperative_groups;
constexpr int NWAVES = 8;
constexpr int BATCH = 4, SEQ = 4096, DM = 2048, NH = 8, HD = 128, DA = 1024, DG = 1024, DFF = 8192, NIN = 5128, NIN2 = 5120, CHUNK = 128;
constexpr int M = BATCH * SEQ;
constexpr float EPS = 1e-6f;
constexpr size_t MiB = 1u << 20;
constexpr size_t WS_SSA = 1 * MiB, WS_SSG = 2 * MiB;
constexpr size_t WS_LF = 4 * MiB, WS_NB = 5 * MiB, WS_WSB = 6 * MiB, WS_LNST = 8 * MiB;
constexpr size_t WS_W1 = 12 * MiB, WS_WO = 32 * MiB, WS_WF1 = 40 * MiB, WS_X1B = 72 * MiB;
constexpr size_t WS_Y16 = 8 * MiB;
constexpr size_t WS_WF2 = 136 * MiB;
constexpr size_t WS_HID = 168 * MiB;
constexpr size_t WS_XN = 168 * MiB, WS_Q = 232 * MiB, WS_K = 264 * MiB, WS_V = 296 * MiB, WS_U = 328 * MiB, WS_YG = 360 * MiB, WS_ATT = 392 * MiB, WS_GM = 424 * MiB, WS_END = 456 * MiB;
constexpr int LDS_BYTES = 147456;
#define LAS __attribute__((address_space(3)))
typedef unsigned short bf16;
typedef unsigned v4u __attribute__((ext_vector_type(4)));
typedef unsigned v2u __attribute__((ext_vector_type(2)));
typedef float f32x4 __attribute__((ext_vector_type(4)));
typedef float f32x2 __attribute__((ext_vector_type(2)));
typedef short bf16x8 __attribute__((ext_vector_type(8)));
#define LDS_WAIT() asm volatile("s_waitcnt lgkmcnt(0)" ::: "memory")
__device__ __forceinline__ unsigned f2bf(float f) { unsigned u = __builtin_bit_cast(unsigned, f); return (u + 0x7fffu + ((u >> 16) & 1u)) >> 16; }
__device__ __forceinline__ unsigned pk2(float lo, float hi) { return f2bf(lo) | (f2bf(hi) << 16); }
__device__ __forceinline__ float bf_lo(unsigned w) { return __uint_as_float(w << 16); }
__device__ __forceinline__ float bf_hi(unsigned w) { return __uint_as_float(w & 0xffff0000u); }
__device__ __forceinline__ float wave_sum(float v) {
#pragma unroll
    for (int o = 1; o < 64; o <<= 1) v += __shfl_xor(v, o);
    return v;
}
__device__ __forceinline__ void p0_transpose_item(const float* W, int ldw, int K, int nblk, bf16* WT, int row_off, const float* gk, LAS float* scr, int item, int lane) {
    const int kb = item / nblk, nb = item % nblk, k0 = 64 * kb, n0 = 64 * nb;
    const int r = lane >> 4, c = lane & 15;
    f32x4 v[16];
#pragma unroll
    for (int i = 0; i < 16; ++i) v[i] = *(const f32x4*)(W + (size_t)(k0 + 4 * i + r) * ldw + n0 + 4 * c);
#pragma unroll
    for (int i = 0; i < 16; ++i) { const int k = 4 * i + r; f32x4 t = v[i]; if (gk) t = t * gk[k0 + k];
        *(LAS f32x4*)(scr + k * 64 + ((4 * c) ^ (((k >> 3) & 7) << 2))) = t; }
    LDS_WAIT(); asm volatile("" ::: "memory");
    const int nrow = lane >> 3, kc = lane & 7;
#pragma unroll
    for (int j = 0; j < 8; ++j) { const int n = 8 * j + nrow; const LAS float* sp = scr + (8 * kc) * 64 + (n ^ (kc << 2));
        v4u o; o.x = pk2(sp[0 * 64], sp[1 * 64]); o.y = pk2(sp[2 * 64], sp[3 * 64]); o.z = pk2(sp[4 * 64], sp[5 * 64]); o.w = pk2(sp[6 * 64], sp[7 * 64]);
        *(v4u*)(WT + (size_t)(row_off + n0 + n) * K + k0 + 8 * kc) = o; }
    LDS_WAIT(); asm volatile("" ::: "memory");
}

#define XB_TMO      128
#define XB_XCNT(j)  (256  + 64 * (j))
#define XB_XSUB(j)  (1280 + 64 * (j))
#define XB_XGEN(j)  (2304 + 64 * (j))
#define XB_TOP      3328
#define XB_TOPGEN   3392
#define XCD_BAR_WORDS 3456
#define XB_SPIN_CAP (1u << 18)

__device__ __forceinline__ unsigned xb_ld(unsigned* p)              { return __hip_atomic_load(p, __ATOMIC_RELAXED, __HIP_MEMORY_SCOPE_AGENT); }
__device__ __forceinline__ unsigned xb_add(unsigned* p, unsigned v) { return __hip_atomic_fetch_add(p, v, __ATOMIC_RELAXED, __HIP_MEMORY_SCOPE_AGENT); }
__device__ __forceinline__ unsigned xb_xcc_id() { return (unsigned)__builtin_amdgcn_s_getreg((3 << 11) | 20) & 0xFu; }
#define XB_SPIN(cond, bar) do { unsigned _sp = 0; while (cond) { __builtin_amdgcn_s_sleep(1); \
    if ((++_sp & 255u) == 0u) { if (xb_ld(&(bar)[XB_TMO])) break; if (_sp > XB_SPIN_CAP) { atomicAdd(&(bar)[XB_TMO], 1u); break; } } } } while (0)

struct XcdBarrier {
    unsigned* bar; unsigned x;
    volatile LAS unsigned* st;
};

__device__ __forceinline__ XcdBarrier xcd_barrier_post(unsigned* bar, volatile LAS unsigned* st, const int tid) {
    XcdBarrier b; b.bar = bar; b.x = xb_xcc_id(); b.st = st;
    if (tid == 0) (void)xb_add(&bar[XB_XCNT(b.x)], 1u);
    return b;
}
__device__ __forceinline__ void xcd_barrier_complete(unsigned* bar, unsigned x, unsigned& nloc, unsigned& nx) {
    const unsigned G = gridDim.x * gridDim.y * gridDim.z;
    unsigned sum, cnt, mine, sp = 0u;
    for (;;) {
        sum = 0u; cnt = 0u; mine = 0u;
#pragma unroll
        for (unsigned j = 0; j < 16; ++j) { const unsigned c = xb_ld(&bar[XB_XCNT(j)]); sum += c; cnt += (c > 0u) ? 1u : 0u; mine = (j == x) ? c : mine; }
        if (sum == G) break;
        __builtin_amdgcn_s_sleep(1);
        if ((++sp & 255u) == 0u) { if (xb_ld(&bar[XB_TMO])) break; if (sp > XB_SPIN_CAP) { atomicAdd(&bar[XB_TMO], 1u); break; } }
    }
    nloc = mine > 0u ? mine : 1u; nx = cnt > 0u ? cnt : 1u;
}

__device__ __forceinline__ void xcd_barrier(const XcdBarrier& b, const int tid) {
    asm volatile("s_waitcnt vmcnt(0)" ::: "memory");
    __syncthreads();
    if (tid == 0) {
        unsigned* bar = b.bar;
        __builtin_amdgcn_s_waitcnt(0);
        unsigned nloc = b.st[0], nx = b.st[1];
        if (nloc == 0u) { xcd_barrier_complete(bar, b.x, nloc, nx); b.st[0] = nloc; b.st[1] = nx; }
        const unsigned old = xb_add(&bar[XB_XSUB(b.x)], 1u);
        const unsigned gen = old / nloc;
        if (old + 1u == (gen + 1u) * nloc) {
            __builtin_amdgcn_fence(__ATOMIC_RELEASE, "agent");
            asm volatile("s_waitcnt vmcnt(0)" ::: "memory");
            const unsigned og = xb_add(&bar[XB_TOP], 1u);
            const unsigned tg = og / nx;
            if (og + 1u == (tg + 1u) * nx) xb_add(&bar[XB_TOPGEN], 1u);
            else XB_SPIN(xb_ld(&bar[XB_TOPGEN]) == tg, bar);
            __builtin_amdgcn_fence(__ATOMIC_ACQUIRE, "agent");
            xb_add(&bar[XB_XGEN(b.x)], 1u);
            asm volatile("s_waitcnt vmcnt(0)" ::: "memory");
        } else {
            XB_SPIN(xb_ld(&bar[XB_XGEN(b.x)]) == gen, bar);
            __builtin_amdgcn_fence(__ATOMIC_ACQUIRE, "agent");
            asm volatile("s_waitcnt vmcnt(0)" ::: "memory");
        }
    }
    __syncthreads();
}

#define WGM_P1 8
#define WGM_P3 4
#define WGM_P4 4
#define WGM_P5 4
struct Args { const float* in[15]; float* out; unsigned char* ws; };
__device__ __forceinline__ int lane_id_fresh() { int z = 0; asm volatile("" : "+v"(z)); return __builtin_amdgcn_mbcnt_hi(~0u, __builtin_amdgcn_mbcnt_lo(~0u, z)); }
__device__ __forceinline__ att::BlockRef mk_block_ref(int LL, int ps, const bf16* Qb, const bf16* Kb, const bf16* Vb, bf16* MG, const float* NB, float* SSA) {
    constexpr int NQB = SEQ / 256, NX = NQB / 2;
    const int bh = LL / NX, xx = LL % NX, qb = ps ? NQB - 1 - xx : xx, b = bh / NH, h = bh % NH; att::BlockRef r;
    r.Q = (const att::bf16*)Qb + ((size_t)bh * SEQ + (size_t)qb * 256) * HD; r.K = (const att::bf16*)Kb + (size_t)bh * SEQ * HD; r.V = (const att::bf16*)Vb + (size_t)bh * SEQ * HD;
    const size_t row0 = (size_t)b * SEQ + (size_t)qb * 256;
    r.O = (att::bf16*)MG + row0 * DM + h * HD; r.NB = NB + (size_t)bh * SEQ; r.SS = SSA + row0 * 8 + h; r.P0 = qb * 256; return r;
}

__global__ void __launch_bounds__(NWAVES * 64, 2) mk_fwd(Args args) {
    extern __shared__ __attribute__((aligned(16))) unsigned char lds[];
    cg::grid_group grid = cg::this_grid();
    LAS unsigned char* ldsl = (LAS unsigned char*)lds;
    const int wave = __builtin_amdgcn_readfirstlane((int)threadIdx.x >> 6);
#define FRESH_TID const int lane = lane_id_fresh(), tid = wave * 64 + lane; (void)tid
    const int G = gridDim.x; const int bx = blockIdx.x; const int vcu = (G % 8 == 0) ? (bx % 8) * (G / 8) + bx / 8 : bx;
    volatile LAS unsigned* bst = (volatile LAS unsigned*)(ldsl + 131072 + 64);
    if (threadIdx.x == 0) { bst[0] = 0u; bst[1] = 0u; }
    typedef const __attribute__((address_space(4))) Args* ArgP;
#define SEAM() do { FRESH_TID; xcd_barrier(xbar, tid); } while (0)
    ArgP ap = (ArgP)__builtin_amdgcn_kernarg_segment_ptr();
#define PHASE_ARGS FRESH_TID; ArgP A_ = ap; asm volatile("" : "+s"(A_)); unsigned char* ws = A_->ws; (void)ws
#define INP(i) (A_->in[i])
    const int gw = vcu * NWAVES + wave, NGW = G * NWAVES;
    if (ap->ws == nullptr) { grid.sync(); return; }
    XcdBarrier xbar; { FRESH_TID; xbar = xcd_barrier_post((unsigned*)ap->ws, bst, tid); }

#ifndef REPS
#define REPS 0x1111111111ull
#endif
#define REP(k) for (int rep_ = 0; rep_ < (int)((REPS >> (4 * (k))) & 15); ++rep_)
    REP(0) {
        PHASE_ARGS; const float* x = INP(0); const float* g_mix = INP(1); const float* w_in = INP(2); const float* b_f = INP(3); const float* w_s = INP(6); const float* g_att = INP(8); const float* g_gm = INP(9); const float* w_out = INP(10); const float* g_ffn = INP(11); const float* w_ff1 = INP(12); const float* w_ff2 = INP(13);
        bf16* W1t = (bf16*)(ws + WS_W1); bf16* WOt = (bf16*)(ws + WS_WO); bf16* WF1t = (bf16*)(ws + WS_WF1); bf16* WF2t = (bf16*)(ws + WS_WF2); bf16* WSB = (bf16*)(ws + WS_WSB); bf16* XN = (bf16*)(ws + WS_XN); float* LF = (float*)(ws + WS_LF);
        LAS float* scr = (LAS float*)(ldsl + wave * 16384);
        constexpr int I_A = 32 * 48, I_B = 32 * 32, I_O = 32 * 32, I_1 = 32 * 128, I_2 = 128 * 32, NITEMS = I_A + I_B + I_O + I_1 + I_2;
        for (int it = gw; it < NITEMS; it += NGW) {
            int r = it;
            if (r < I_A) { p0_transpose_item(w_in, NIN, DM, 48, W1t, 0, nullptr, scr, r, lane); continue; } r -= I_A;
            if (r < I_B) { p0_transpose_item(w_in + 3080, NIN, DM, 32, W1t, 3072, nullptr, scr, r, lane); continue; } r -= I_B;
            if (r < I_O) { p0_transpose_item(w_out, DM, DM, 32, WOt, 0, (r / 32) * 64 < DA ? g_att : g_gm - DA, scr, r, lane); continue; } r -= I_O;
            if (r < I_1) { p0_transpose_item(w_ff1, DFF, DM, 128, WF1t, 0, g_ffn, scr, r, lane); continue; } r -= I_1;
            p0_transpose_item(w_ff2, DM, DFF, 32, WF2t, 0, nullptr, scr, r, lane);
        }
        for (int i = bx * 512 + tid; i < 8 * 128 * 128 / 8; i += G * 512) { const int e0 = i * 8, t = (e0 >> 7) & 127, s0 = e0 & 127;
            const f32x4 a = *(const f32x4*)(w_s + e0), b = *(const f32x4*)(w_s + e0 + 4); float v[8] = {a[0], a[1], a[2], a[3], b[0], b[1], b[2], b[3]};
#pragma unroll
            for (int e = 0; e < 8; ++e) if (s0 + e > t) v[e] = 0.f;
            v4u o; o.x = pk2(v[0], v[1]); o.y = pk2(v[2], v[3]); o.z = pk2(v[4], v[5]); o.w = pk2(v[6], v[7]); *(v4u*)(WSB + e0) = o; }
        __syncthreads();
        LAS f32x4* WF = (LAS f32x4*)ldsl;
        for (int k = tid; k < DM; k += 512) { const f32x4 a = *(const f32x4*)(w_in + (size_t)k * NIN + 3072), b = *(const f32x4*)(w_in + (size_t)k * NIN + 3076);
            const int q4 = k >> 2, i = k & 3, j = q4 >> 6, l = q4 & 63; WF[((j * 4 + i) * 2 + 0) * 64 + l] = a; WF[((j * 4 + i) * 2 + 1) * 64 + l] = b; }
        __syncthreads();
        f32x4 gv[8];
#pragma unroll
        for (int j = 0; j < 8; ++j) gv[j] = *((const f32x4*)g_mix + lane + 64 * j);
        f32x4 nx[8];
#pragma unroll
        for (int j = 0; j < 8; ++j) nx[j] = *((const f32x4*)(x + (size_t)gw * DM) + lane + 64 * j);
        for (int m = gw; m < M; m += NGW) {
            asm volatile("" ::: "memory");
            f32x4 v[8]; float s = 0.f;
#pragma unroll
            for (int j = 0; j < 8; ++j) { v[j] = nx[j]; s += (v[j][0] * v[j][0] + v[j][1] * v[j][1]) + (v[j][2] * v[j][2] + v[j][3] * v[j][3]); }
            if (m + NGW < M) {
#pragma unroll
                for (int j = 0; j < 8; ++j) nx[j] = *((const f32x4*)(x + (size_t)(m + NGW) * DM) + lane + 64 * j); }
            const float rs = 1.0f / sqrtf(wave_sum(s) * (1.f / DM) + EPS);
            unsigned long long* o8 = (unsigned long long*)(XN + (size_t)m * DM) + lane;
            float zf[8] = {0.f, 0.f, 0.f, 0.f, 0.f, 0.f, 0.f, 0.f};
#pragma unroll
            for (int j = 0; j < 8; ++j) { v[j] = v[j] * rs * gv[j];
                o8[64 * j] = (unsigned long long)pk2(v[j][0], v[j][1]) | ((unsigned long long)pk2(v[j][2], v[j][3]) << 32);
#pragma unroll
                for (int i = 0; i < 4; ++i) { const f32x4 wa = WF[((j * 4 + i) * 2 + 0) * 64 + lane], wb = WF[((j * 4 + i) * 2 + 1) * 64 + lane]; const float hv = v[j][i];
                    zf[0] += hv * wa[0]; zf[1] += hv * wa[1]; zf[2] += hv * wa[2]; zf[3] += hv * wa[3]; zf[4] += hv * wb[0]; zf[5] += hv * wb[1]; zf[6] += hv * wb[2]; zf[7] += hv * wb[3]; } }
            float mine = 0.f;
#pragma unroll
            for (int h = 0; h < 8; ++h) { const float t = wave_sum(zf[h]); if (lane == h) mine = t; }
            if (lane < 8) { const float a = mine + b_f[lane]; const float lf = fminf(a, 0.f) - log1pf(expf(-fabsf(a)));
                const int b = m / SEQ, sidx = m % SEQ; LF[(size_t)(b * NH + lane) * SEQ + sidx] = lf; }
        }
    }
    SEAM();

    REP(1) if (bx < BATCH * NH) {
        PHASE_ARGS; float* LF = (float*)(ws + WS_LF); float* NB = (float*)(ws + WS_NB);
        const float* src = LF + (size_t)bx * SEQ + wave * 512 + lane * 8; float* dst = NB + (size_t)bx * SEQ + wave * 512 + lane * 8;
        const f32x4 a = *(const f32x4*)src, b = *(const f32x4*)(src + 4);
        float p[8]; p[0] = a[0]; p[1] = p[0] + a[1]; p[2] = p[1] + a[2]; p[3] = p[2] + a[3]; p[4] = p[3] + b[0]; p[5] = p[4] + b[1]; p[6] = p[5] + b[2]; p[7] = p[6] + b[3];
        float incl = p[7];
#pragma unroll
        for (int o = 1; o < 64; o <<= 1) { const float t = __shfl_up(incl, o); if (lane >= o) incl += t; }
        LAS float* wt = (LAS float*)ldsl;
        if (lane == 63) wt[wave] = incl;
        __syncthreads();
        float off = incl - p[7];
#pragma unroll
        for (int w = 0; w < NWAVES - 1; ++w) if (w < wave) off += wt[w];
        const float c = -11.313708498984761f;
        *(f32x4*)dst = (f32x4){(off + p[0]) * c, (off + p[1]) * c, (off + p[2]) * c, (off + p[3]) * c};
        *(f32x4*)(dst + 4) = (f32x4){(off + p[4]) * c, (off + p[5]) * c, (off + p[6]) * c, (off + p[7]) * c};
        __syncthreads();
    }
    REP(2) {
        PHASE_ARGS; bf16* XN = (bf16*)(ws + WS_XN); bf16* W1t = (bf16*)(ws + WS_W1); bf16* Qb = (bf16*)(ws + WS_Q); bf16* Kb = (bf16*)(ws + WS_K); bf16* Vb = (bf16*)(ws + WS_V); bf16* Ub = (bf16*)(ws + WS_U); bf16* Yb = (bf16*)(ws + WS_YG); float* LNST = (float*)(ws + WS_LNST);
        pg8::Gemm g{XN, W1t, M, NIN2, DM}; pg8::StaticOrder S; S.init(M, NIN2, G, bx, WGM_P1);
        pg8::EpiIn E{Qb, Kb, Vb, Ub, Yb, LNST};
        pg8::gemm_phase<pg8::EpiIn, pg8::StaticOrder, true, true>(ldsl, g, S, E, tid);
    }
    SEAM();

    {
        PHASE_ARGS; const float* ln_g = INP(4); const float* ln_b = INP(5); const float* b_s = INP(7);
        bf16* Qb = (bf16*)(ws + WS_Q); bf16* Kb = (bf16*)(ws + WS_K); bf16* Vb = (bf16*)(ws + WS_V); bf16* Ub = (bf16*)(ws + WS_U); bf16* Yb = (bf16*)(ws + WS_YG); bf16* MG = (bf16*)(ws + WS_XN);
        float* NB = (float*)(ws + WS_NB); float* LNST = (float*)(ws + WS_LNST); bf16* WSB = (bf16*)(ws + WS_WSB); float* SSA = (float*)(ws + WS_SSA); float* SSG = (float*)(ws + WS_SSG);
        char* shm = (char*)lds;
        constexpr int NQB = SEQ / 256, NX = NQB / 2, TOTAL = BATCH * NH * NX;
#ifndef ATT_DUP
#define ATT_DUP 1
#endif
#ifndef SYNC_DUP
#define SYNC_DUP 0
#endif
        for (int sd_ = 0; sd_ < SYNC_DUP; ++sd_) SEAM();
        REP(4) {
            const int r32 = lane & 31, hi = lane >> 5, rg = wave & 3, dh = wave >> 2;
            float* st = (float*)(shm + att::OFF_WS);
            char* V_lds = shm;
            const int vb0 = (int)(uintptr_t)V_lds + att::v_rd_base(lane);
            const int sr = tid >> 4, sc = (tid & 15) * 8;
#ifndef GM_DUP
#define GM_DUP 1
#endif
            constexpr int NUNITS = (M / CHUNK) * NH * GM_DUP;
            int hprev = -1;
            bf16x8 pw[8];
            v4u yv[4]; f32x4 sv[2]; unsigned uv[16];
            const unsigned ulane = (unsigned)((4 * hi) * DG + 2 * r32) * 2u, olane = (unsigned)((4 * hi) * DM + 2 * r32) * 2u;
#define GM_LOAD_Y(un) do { const int ch_ = ((un) >> 3) % (M / CHUNK), h_ = (un) & 7; const size_t m_ = (size_t)ch_ * CHUNK;                     \
                _Pragma("unroll") for (int q = 0; q < 4; ++q) yv[q] = *(const v4u*)(Yb + (m_ + q * 32 + sr) * DG + h_ * HD + sc);          \
                const f32x4* p_ = (const f32x4*)(LNST + (m_ + (tid >> 2)) * 32) + 2 * (tid & 3); sv[0] = p_[0]; sv[1] = p_[1]; } while (0)
#define GM_LOAD_U(un) do { const int ch_ = ((un) >> 3) % (M / CHUNK), h_ = (un) & 7; const char* ub_ = (const char*)(Ub + ((size_t)ch_ * CHUNK + rg * 32) * DG + h_ * HD + dh * 64);   \
                _Pragma("unroll") for (int r = 0; r < 16; ++r) { const int rc_ = (r & 3) + 8 * (r >> 2); uv[r] = *(const unsigned*)(ub_ + (size_t)(rc_ * DG) * 2 + ulane); } } while (0)
            int unit = vcu;
            if (unit < NUNITS) { GM_LOAD_Y(unit); GM_LOAD_U(unit); }
            for (; unit < NUNITS; unit += G) {
                const int ch = (unit >> 3) % (M / CHUNK), h = unit & 7; const size_t m0 = (size_t)ch * CHUNK;
                if (h != hprev) { hprev = h;
                    const bf16* wrow = WSB + ((size_t)h * CHUNK + rg * 32 + r32) * CHUNK + 8 * hi;
#pragma unroll
                    for (int i = 0; i < 8; ++i) pw[i] = *(const bf16x8*)(wrow + 16 * i); }
                const f32x4 g0 = *(const f32x4*)(ln_g + h * HD + sc), g1 = *(const f32x4*)(ln_g + h * HD + sc + 4), c0 = *(const f32x4*)(ln_b + h * HD + sc), c1 = *(const f32x4*)(ln_b + h * HD + sc + 4);
                { float s1 = (sv[0][0] + sv[0][2]) + (sv[1][0] + sv[1][2]), s2 = (sv[0][1] + sv[0][3]) + (sv[1][1] + sv[1][3]);
                  s1 += __shfl_xor(s1, 1); s1 += __shfl_xor(s1, 2); s2 += __shfl_xor(s2, 1); s2 += __shfl_xor(s2, 2);
                  if ((tid & 3) == 0) { const float mu = s1 * (1.f / DG), var = fmaxf(s2 * (1.f / DG) - mu * mu, 0.f); st[2 * (tid >> 2)] = mu; st[2 * (tid >> 2) + 1] = 1.0f / sqrtf(var + EPS); } }
                __syncthreads();
                { const int cpos = ((sc >> 6) * 2) * 32 + ((sc & 63) >> 1);
#pragma unroll
                  for (int q = 0; q < 4; ++q) { const int key = q * 32 + sr;
                    const v4u w = yv[q]; const float mu = st[2 * key], rsd = st[2 * key + 1];
                    const float e0 = (bf_lo(w.x) - mu) * rsd * g0[0] + c0[0], e1 = (bf_hi(w.x) - mu) * rsd * g0[1] + c0[1], e2 = (bf_lo(w.y) - mu) * rsd * g0[2] + c0[2], e3 = (bf_hi(w.y) - mu) * rsd * g0[3] + c0[3];
                    const float e4 = (bf_lo(w.z) - mu) * rsd * g1[0] + c1[0], e5 = (bf_hi(w.z) - mu) * rsd * g1[1] + c1[1], e6 = (bf_lo(w.w) - mu) * rsd * g1[2] + c1[2], e7 = (bf_hi(w.w) - mu) * rsd * g1[3] + c1[3];
                    char* vt = V_lds + (q >> 1) * att::SHM_V; const int krow = (q & 1) * 32 + sr;
                    *(v2u*)(vt + att::v_st(krow, cpos)) = (v2u){pk2(e0, e2), pk2(e4, e6)};
                    *(v2u*)(vt + att::v_st(krow, cpos + 32)) = (v2u){pk2(e1, e3), pk2(e5, e7)}; } }
                att::f32x16 o2[2];
                { const char* bb = (const char*)(b_s + h * CHUNK + rg * 32);
#pragma unroll
                  for (int g = 0; g < 4; ++g) { const f32x4 bv = *(const f32x4*)(bb + (size_t)(8 * g) * 4 + (unsigned)(4 * hi) * 4u);
#pragma unroll
                      for (int i = 0; i < 4; ++i) { o2[0][4 * g + i] = bv[i]; o2[1][4 * g + i] = bv[i]; } } }
                __syncthreads();
                const int nu = unit + G;
                if (nu < NUNITS) GM_LOAD_Y(nu);
                if (dh == 0) att::pv_half<0, 0>(o2, vb0, pw[0], pw[1], pw[2], pw[3]); else att::pv_half<0, 2>(o2, vb0, pw[0], pw[1], pw[2], pw[3]);
                if (rg >= 2) { if (dh == 0) att::pv_half<1, 0>(o2, vb0, pw[4], pw[5], pw[6], pw[7]); else att::pv_half<1, 2>(o2, vb0, pw[4], pw[5], pw[6], pw[7]); }
                char* ob = (char*)(MG + (m0 + rg * 32) * DM + DA + h * HD + dh * 64); char* sb = (char*)(SSG + (m0 + rg * 32) * 16 + h * 2 + dh);
                float sqv[16];
#pragma unroll
                for (int r = 0; r < 16; ++r) { const int rc = (r & 3) + 8 * (r >> 2);
                    const float v0 = bf_lo(uv[r]) * o2[0][r], v1 = bf_hi(uv[r]) * o2[1][r];
                    const unsigned w = att::cvtpk(v0, v1); const float r0 = bf_lo(w), r1 = bf_hi(w); sqv[r] = r0 * r0 + r1 * r1;
                    *(unsigned*)(ob + (size_t)(rc * DM) * 2 + olane) = w; }
                if (nu < NUNITS) GM_LOAD_U(nu);
                { const float tot = att::rowsum16(sqv, r32); const int rr = r32 >> 1;
                  if ((r32 & 1) == 0) *(float*)(sb + (size_t)(((rr & 3) + 8 * (rr >> 2)) * 16) * 4 + (unsigned)(4 * hi * 16) * 4u) = tot; }
                __syncthreads();
            }
#undef GM_LOAD_Y
#undef GM_LOAD_U
        }
        __syncthreads();
        if (vcu < TOTAL) {
            int L = vcu, pass = 0, par = 0;
#define mkref(LL, ps) mk_block_ref((LL) % TOTAL, (ps), Qb, Kb, Vb, MG, NB, SSA)
            att::BlockRef cur = mkref(L, 0);
            att::Seam S;
            att::prime(cur, shm, S, tid);
            for (;;) {
                const bool more_pass = pass == 0, more_item = L + G < TOTAL * ATT_DUP, last = !more_pass && !more_item;
                int passn = pass + 1, Ln = L;
                if (!more_pass) { passn = 0; Ln = more_item ? L + G : L; }
                const att::BlockRef nxt = last ? cur : mkref(Ln, passn);
                att::block(cur, nxt, shm, S, par, tid);
                if (last) break;
                cur = nxt; pass = passn; L = Ln; par ^= 1;
            }
        }
    }
    SEAM();

    REP(6) {
        PHASE_ARGS; const float* x = INP(0); bf16* XN = (bf16*)(ws + WS_XN); bf16* WOt = (bf16*)(ws + WS_WO); bf16* X1B = (bf16*)(ws + WS_X1B); const float* SSA = (const float*)(ws + WS_SSA); const float* SSG = (const float*)(ws + WS_SSG);
        pg8::Gemm g{XN, WOt, M, DM, DM}; pg8::StaticOrder S; S.init(M, DM, G, bx, WGM_P3);
        LAS f32x2* tab = (LAS f32x2*)(ldsl + 131072 + 256);
        { pg8::Unit uu; int nun = 0; while (nun < 7 && S.next(nun, uu)) ++nun;
          for (int idx = tid; idx < nun * 256; idx += 512) { S.next(idx >> 8, uu); const size_t row = (size_t)uu.pm * 256 + (idx & 255);
              const f32x4 a0 = *(const f32x4*)(SSA + row * 8), a1 = *(const f32x4*)(SSA + row * 8 + 4);
              const f32x4 q0 = *(const f32x4*)(SSG + row * 16), q1 = *(const f32x4*)(SSG + row * 16 + 4), q2 = *(const f32x4*)(SSG + row * 16 + 8), q3 = *(const f32x4*)(SSG + row * 16 + 12);
              const float sa = ((a0[0] + a0[1]) + (a0[2] + a0[3])) + ((a1[0] + a1[1]) + (a1[2] + a1[3]));
              const float sg = (((q0[0] + q0[1]) + (q0[2] + q0[3])) + ((q1[0] + q1[1]) + (q1[2] + q1[3]))) + (((q2[0] + q2[1]) + (q2[2] + q2[3])) + ((q3[0] + q3[1]) + (q3[2] + q3[3])));
              const float rsa = 1.0f / sqrtf(sa * (1.f / 1024.f) + EPS), rsg = 1.0f / sqrtf(sg * (1.f / 1024.f) + EPS);
              tab[idx] = (f32x2){rsa / rsg, rsg}; }
          __syncthreads(); }
        pg8::EpiRes E{x, X1B, tab};
        pg8::gemm_phase<pg8::EpiRes, pg8::StaticOrder, true, true>(ldsl, g, S, E, tid);
    }
    SEAM();

    REP(7) {
        PHASE_ARGS; bf16* X1B = (bf16*)(ws + WS_X1B); bf16* WF1t = (bf16*)(ws + WS_WF1); bf16* HID = (bf16*)(ws + WS_HID);
        pg8::Gemm g{X1B, WF1t, M, DFF, DM}; pg8::StaticOrder S; S.init(M, DFF, G, bx, WGM_P4);
        pg8::EpiRelu2 E{HID, DFF};
        pg8::gemm_phase<pg8::EpiRelu2, pg8::StaticOrder, true, true>(ldsl, g, S, E, tid);
    }
    SEAM();

    REP(8) {
        PHASE_ARGS; bf16* HID = (bf16*)(ws + WS_HID); bf16* WF2t = (bf16*)(ws + WS_WF2); bf16* Y16 = (bf16*)(ws + WS_Y16);
        pg8::Gemm g{HID, WF2t, M, DM, DFF}; pg8::StaticOrder S; S.init(M, DM, G, bx, WGM_P5);
        pg8::EpiY16 E{Y16};
        pg8::gemm_phase<pg8::EpiY16, pg8::StaticOrder, true, true>(ldsl, g, S, E, tid);
    }
    SEAM();

    REP(9) {
        PHASE_ARGS; const float* g_fin = INP(14); const bf16* X1B = (const bf16*)(ws + WS_X1B); const bf16* Y16 = (const bf16*)(ws + WS_Y16); float* OUT = A_->out;
        const bool xmap = (G % 8 == 0) && ((M / 8) % ((G / 8) * NWAVES) == 0); const int wpx = (G / 8) * NWAVES, nit = xmap ? (M / 8) / wpx : (M + NGW - 1) / NGW;
        for (int it = 0; it < nit; ++it) {
            const int m = xmap ? (vcu / (G / 8)) * (M / 8) + (nit - 1 - it) * wpx + (vcu % (G / 8)) * NWAVES + wave : gw + it * NGW;
            if (m >= M) break;
            const v2u* xr = (const v2u*)(X1B + (size_t)m * DM) + lane; const v2u* yr = (const v2u*)(Y16 + (size_t)m * DM) + lane;
            f32x4 v[8], y[8]; float s = 0.f;
#pragma unroll
            for (int j = 0; j < 8; ++j) { const v2u w = xr[64 * j], wy = yr[64 * j]; y[j] = (f32x4){bf_lo(wy.x), bf_hi(wy.x), bf_lo(wy.y), bf_hi(wy.y)}; v[j] = (f32x4){bf_lo(w.x), bf_hi(w.x), bf_lo(w.y), bf_hi(w.y)}; s += (v[j][0] * v[j][0] + v[j][1] * v[j][1]) + (v[j][2] * v[j][2] + v[j][3] * v[j][3]); }
            const float r1 = 1.0f / (wave_sum(s) * (1.f / DM) + EPS);
            float s2 = 0.f;
#pragma unroll
            for (int j = 0; j < 8; ++j) { v[j] = v[j] + y[j] * r1; s2 += (v[j][0] * v[j][0] + v[j][1] * v[j][1]) + (v[j][2] * v[j][2] + v[j][3] * v[j][3]); }
            const float r2 = 1.0f / sqrtf(wave_sum(s2) * (1.f / DM) + EPS);
            f32x4* orow = (f32x4*)(OUT + (size_t)m * DM) + lane;
#pragma unroll
            for (int j = 0; j < 8; ++j) orow[64 * j] = v[j] * r2 * *((const f32x4*)g_fin + lane + 64 * j);
        }
    }
}

extern "C" void kernel_launch(void* const* d_in, const int* in_sizes, int n_in, void* d_out, int out_size, void* d_ws, size_t ws_size, hipStream_t stream) {
    static int grid = 0;
    if (grid == 0) {
        if (n_in != 15 || in_sizes[0] != M * DM || out_size != M * DM || ws_size < WS_END) { fprintf(stderr, "kernel_launch: shape/workspace mismatch (n_in %d, in0 %d, out %d, ws %zu < %zu)\n", n_in, n_in > 0 ? in_sizes[0] : -1, out_size, ws_size, (size_t)WS_END); grid = -1; return; }
        int dev = 0, cus = 0, per_cu = 0;
        hipGetDevice(&dev); hipDeviceGetAttribute(&cus, hipDeviceAttributeMultiprocessorCount, dev);
        if (hipFuncSetAttribute((const void*)mk_fwd, hipFuncAttributeMaxDynamicSharedMemorySize, LDS_BYTES) != hipSuccess) { fprintf(stderr, "kernel_launch: hipFuncSetAttribute failed\n"); grid = -1; return; }
        if (hipOccupancyMaxActiveBlocksPerMultiprocessor(&per_cu, (const void*)mk_fwd, NWAVES * 64, LDS_BYTES) != hipSuccess || per_cu < 1) { fprintf(stderr, "kernel_launch: occupancy query says %d\n", per_cu); per_cu = 1; }
        (void)hipGetLastError();
        grid = cus * per_cu;
    }
    if (grid < 0) return;
    if (hipMemsetAsync(d_ws, 0, 16384, stream) != hipSuccess) { fprintf(stderr, "kernel_launch: hipMemsetAsync of the barrier words failed\n"); return; }
    Args a{};
    for (int i = 0; i < 15; ++i) a.in[i] = (const float*)d_in[i];
    a.out = (float*)d_out; a.ws = (unsigned char*)d_ws;
    void* kargs[] = {&a};
    hipError_t e = hipLaunchCooperativeKernel((const void*)mk_fwd, dim3(grid), dim3(NWAVES * 64), kargs, LDS_BYTES, stream);
    if (e != hipSuccess) fprintf(stderr, "cooperative launch failed: %s (grid %d)\n", hipGetErrorString(e), grid);
}
```
